# Optimizing an MI355X kernel written in HIP

```python
import math
import jax
import jax.numpy as jnp
from jax import lax
import numpy as np

D_MODEL = 1024
BATCH = 2
SEQ = 16384
DEPTH = 4

GRID_W = 64
CTX_LEN = 256
MIX_W = D_MODEL
GROUP_W = MIX_W // 4
D_FF = 4 * D_MODEL
N_ADA = 6
EPS = 1e-6
GN_EPS = 64e-5
CHUNK = 64

S5_P = 16
S5_G = GROUP_W // S5_P
S5_N = 64

RW_HEAD = 64
RW_HEADS = GROUP_W // RW_HEAD
RW_W_RANK = 32
RW_A_RANK = 32
RW_G_RANK = 64
RW_COLS = 3 * GROUP_W + RW_W_RANK + RW_A_RANK + RW_G_RANK
RW_SPLITS = (GROUP_W, 2 * GROUP_W, 3 * GROUP_W, 3 * GROUP_W + RW_W_RANK, 3 * GROUP_W + RW_W_RANK + RW_A_RANK)

RET_HEADS = 4
RET_DK = GROUP_W // RET_HEADS
RET_DV = GROUP_W // RET_HEADS
ROPE_BASE = 10000.0

GLA_HEADS = 4
GLA_DK = 32
GLA_DV = GROUP_W // GLA_HEADS
GLA_QK = GLA_HEADS * GLA_DK
GLA_RANK = 16
GLA_TAU = 16.0
GLA_COLS = 2 * GLA_QK + 2 * GROUP_W + GLA_RANK
GLA_SPLITS = (GLA_QK, 2 * GLA_QK, 2 * GLA_QK + GROUP_W, 2 * GLA_QK + 2 * GROUP_W)

IN_TOTAL = GROUP_W + RW_COLS + 4 * GROUP_W + GLA_COLS
IN_SPLITS = (GROUP_W, GROUP_W + RW_COLS, GROUP_W + RW_COLS + 4 * GROUP_W)

kernel_name = 'hybrid_s5_rwkv7_retnet_gla_dit'


def _rmsnorm(x, g):
    xf = x.astype(jnp.float32)
    y = xf * lax.rsqrt(jnp.mean(xf * xf, axis=-1, keepdims=True) + EPS)
    return (y * g.astype(jnp.float32)).astype(x.dtype)


def _head_rmsnorm(y, g):
    yf = y.astype(jnp.float32)
    yn = yf * lax.rsqrt(jnp.mean(yf * yf, axis=-1, keepdims=True) + EPS)
    b_, l_, h_, dh = y.shape
    return yn.reshape(b_, l_, h_ * dh) * g.astype(jnp.float32)


def _head_groupnorm(y, g, b):
    yf = y.astype(jnp.float32)
    mu = jnp.mean(yf, axis=-1, keepdims=True)
    var = jnp.mean(jnp.square(yf - mu), axis=-1, keepdims=True)
    yn = (yf - mu) * lax.rsqrt(var + GN_EPS)
    b_, l_, h_, dh = y.shape
    return yn.reshape(b_, l_, h_ * dh) * g.astype(jnp.float32) + b.astype(jnp.float32)


def _gated_head_norm(o, g, ln_g):
    return (_head_rmsnorm(o, ln_g) * jax.nn.silu(g.astype(jnp.float32))).astype(g.dtype)


def _shift_seq(z):
    a, b = jnp.split(z, 2, axis=-1)
    a = jnp.pad(a, ((0, 0), (1, 0), (0, 0)))[:, :-1]
    b = jnp.pad(b, ((0, 0), (0, 1), (0, 0)))[:, 1:]
    return jnp.concatenate([a, b], axis=-1)


def _shift_grid(z, rows):
    b_, l_, c_ = z.shape
    g4 = z.reshape(b_, rows, GRID_W, c_)
    a, b, c, d = jnp.split(g4, 4, axis=-1)
    a = jnp.pad(a, ((0, 0), (0, 0), (1, 0), (0, 0)))[:, :, :-1]
    b = jnp.pad(b, ((0, 0), (0, 0), (0, 1), (0, 0)))[:, :, 1:]
    c = jnp.pad(c, ((0, 0), (1, 0), (0, 0), (0, 0)))[:, :-1]
    d = jnp.pad(d, ((0, 0), (0, 1), (0, 0), (0, 0)))[:, 1:]
    return jnp.concatenate([a, b, c, d], axis=-1).reshape(b_, l_, c_)


def _axial_rope(x, rows_idx, cols_idx):
    half = x.shape[-1] // 2
    nf = half // 2
    inv = ROPE_BASE ** (-jnp.arange(nf, dtype=jnp.float32) / nf)

    def rot(xh, pos):
        ang = pos.astype(jnp.float32)[:, None] * inv[None, :]
        cos = jnp.cos(ang)[None, :, None, :]
        sin = jnp.sin(ang)[None, :, None, :]
        x1 = xh[..., :nf].astype(jnp.float32)
        x2 = xh[..., nf:].astype(jnp.float32)
        return jnp.concatenate([x1 * cos - x2 * sin, x1 * sin + x2 * cos], axis=-1)

    out = jnp.concatenate([rot(x[..., :half], rows_idx), rot(x[..., half:], cols_idx)], axis=-1)
    return out.astype(x.dtype)


def _ssm_combine(e1, e2):
    a1, b1 = e1
    a2, b2 = e2
    return a2 * a1, a2 * b1 + b2


def _s5(u_ctx, u_lat, lam_re, lam_im, log_dt, b_re, b_im, c_re, c_im, d_skip, glu_w, glu_b):
    f32 = jnp.float32
    lam = lax.complex(jnp.minimum(lam_re.astype(f32), -1e-4), lam_im.astype(f32))
    dt = jnp.exp(log_dt.astype(f32))[..., None]
    a_bar = jnp.exp(lam * dt)
    b_bar = ((a_bar - 1.0) / lam)[..., None] * lax.complex(b_re.astype(f32), b_im.astype(f32))
    c_mat = lax.complex(c_re.astype(f32), c_im.astype(f32))

    def run(u, d, h0, reverse):
        b_, l_, _ = u.shape
        ug = u.astype(f32).reshape(b_, l_, S5_G, S5_P)
        if reverse:
            ug = jnp.flip(ug, axis=1)
        bu = jnp.einsum('gnp,blgp->blgn', b_bar[d], ug)
        if h0 is not None:
            bu = bu.at[:, 0].add(a_bar[d] * h0)
        a = jnp.broadcast_to(a_bar[d], (1, l_, S5_G, S5_N))
        _, h = lax.associative_scan(_ssm_combine, (a, bu), axis=1)
        if reverse:
            h = jnp.flip(h, axis=1)
        return h

    def readout(h, d):
        return jnp.einsum('gpn,blgn->blgp', c_mat[d], h).real

    def out(u, hf, hb):
        b_, l_, _ = u.shape
        y = (readout(hf, 0) + readout(hb, 1)).reshape(b_, l_, GROUP_W) + d_skip.astype(f32) * u.astype(f32)
        y = jax.nn.gelu(y)
        y = y * jax.nn.sigmoid(y @ glu_w.astype(f32) + glu_b.astype(f32))
        return y.astype(u.dtype)

    hcf = run(u_ctx, 0, None, False)
    hcb = run(u_ctx, 1, None, True)
    hlf = run(u_lat, 0, hcf[:, -1], False)
    hlb = run(u_lat, 1, hcb[:, 0], True)
    return out(u_ctx, hcf, hcb), out(u_lat, hlf, hlb)


def _rwkv_scan(r, w, k, v, a, b, s0, reverse):
    def tm(t):
        return jnp.moveaxis(t.astype(jnp.float32), 1, 0)

    def step(s, inp):
        r_t, w_t, k_t, v_t, a_t, b_t = inp
        sa = jnp.einsum('bhvk,bhk->bhv', s, a_t)
        s = s * w_t[:, :, None, :] + sa[..., None] * b_t[:, :, None, :] + v_t[..., None] * k_t[:, :, None, :]
        return s, jnp.einsum('bhvk,bhk->bhv', s, r_t)

    xs = (tm(r), tm(w), tm(k), tm(v), tm(a), tm(b))
    s_fin, y = lax.scan(step, s0, xs, reverse=reverse)
    return jnp.moveaxis(y, 0, 1), s_fin


def _rwkv7(z_ctx, z_lat, rows, mu, w0, w_up, a0, a_up, g_up, k_k, k_a, r_k, ln_g, ln_b):
    f32 = jnp.float32

    def prep(z, shifted):
        b_, l_, _ = z.shape

        def hd(t):
            return t.astype(f32).reshape(b_, l_, RW_HEADS, RW_HEAD)

        zm = z + mu * (shifted - z)
        r, k, v, wlo, alo, glo = jnp.split(zm, RW_SPLITS, axis=-1)
        g = jax.nn.sigmoid(glo) @ g_up
        kk = hd(k * k_k)
        kk = kk * lax.rsqrt(jnp.sum(kk * kk, axis=-1, keepdims=True) + 1e-12)
        dirs = []
        for d in range(2):
            w_raw = -jax.nn.softplus(-(w0[d] + jnp.tanh(wlo) @ w_up[d])) - 0.5
            decay = jnp.exp(-jnp.exp(w_raw.astype(f32)))
            a = jax.nn.sigmoid((a0[d] + alo @ a_up[d]).astype(f32))
            k_d = k.astype(f32) * (1.0 + (a - 1.0) * k_a.astype(f32))
            dirs.append((hd(decay), hd(k_d), -kk, kk * hd(a)))
        return hd(r), hd(k), hd(v), g, dirs

    def finish(r, k, v, g, y):
        b_, l_ = r.shape[:2]
        bonus = jnp.sum(r * k * r_k.astype(f32), axis=-1, keepdims=True) * v
        o = _head_groupnorm(y, ln_g, ln_b) + bonus.reshape(b_, l_, GROUP_W)
        return (o * g.astype(f32)).astype(g.dtype)

    rc, kc, vc, gc, dc = prep(z_ctx, _shift_seq(z_ctx))
    rl, kl, vl, gl, dl = prep(z_lat, _shift_grid(z_lat, rows))
    s0 = jnp.zeros((z_lat.shape[0], RW_HEADS, RW_HEAD, RW_HEAD), f32)
    yc_f, sc_f = _rwkv_scan(rc, dc[0][0], dc[0][1], vc, dc[0][2], dc[0][3], s0, False)
    yc_b, sc_b = _rwkv_scan(rc, dc[1][0], dc[1][1], vc, dc[1][2], dc[1][3], s0, True)
    yl_f, _ = _rwkv_scan(rl, dl[0][0], dl[0][1], vl, dl[0][2], dl[0][3], sc_f, False)
    yl_b, _ = _rwkv_scan(rl, dl[1][0], dl[1][1], vl, dl[1][2], dl[1][3], sc_b, True)
    return finish(rc, kc, vc, gc, yc_f + yc_b), finish(rl, kl, vl, gl, yl_f + yl_b)


def _chunked_gla(q, k, v, log_a, s0, reverse):
    if reverse:
        q, k, v, log_a = jnp.flip(q, 1), jnp.flip(k, 1), jnp.flip(v, 1), jnp.flip(log_a, 1)
    b_, l_, h_, _ = q.shape
    dv = v.shape[-1]
    nc = l_ // CHUNK

    def chunks(t):
        return t.astype(jnp.float32).reshape(b_, nc, CHUNK, h_, t.shape[-1]).transpose(1, 0, 3, 2, 4)

    tril = jnp.tril(jnp.ones((CHUNK, CHUNK), dtype=bool))[:, :, None]

    def body(s, inp):
        qc, kc, vc, gc = inp
        bcum = jnp.cumsum(gc, axis=2)
        o_inter = jnp.einsum('bhck,bhkv->bhcv', qc * jnp.exp(bcum), s)
        diff = bcum[:, :, :, None, :] - bcum[:, :, None, :, :]
        dec = jnp.where(tril, jnp.exp(jnp.where(tril, diff, 0.0)), 0.0)
        scores = jnp.einsum('bhtk,bhsk,bhtsk->bhts', qc, kc, dec)
        o = o_inter + jnp.einsum('bhts,bhsv->bhtv', scores, vc)
        b_last = bcum[:, :, -1:, :]
        s = jnp.exp(b_last[:, :, 0, :])[..., None] * s + jnp.einsum('bhsk,bhsv->bhkv', kc * jnp.exp(b_last - bcum), vc)
        return s, o

    s_fin, o = lax.scan(body, s0, (chunks(q), chunks(k), chunks(v), chunks(log_a)))
    o = o.transpose(1, 0, 3, 2, 4).reshape(b_, l_, h_, dv)
    if reverse:
        o = jnp.flip(o, 1)
    return o, s_fin


def _retention(z_ctx, z_lat, rows_idx, cols_idx, decay_logit, ln_g):
    f32 = jnp.float32
    log_gamma = jax.nn.log_sigmoid(decay_logit.astype(f32))

    def prep(z):
        b_, l_, _ = z.shape
        q, k, v, g = jnp.split(z, 4, axis=-1)
        sh = (b_, l_, RET_HEADS, RET_DK)
        return q.reshape(sh), k.reshape(sh) * RET_DK ** -0.5, v.reshape(b_, l_, RET_HEADS, RET_DV), g

    def la(t, d):
        return jnp.broadcast_to(log_gamma[d][None, None, :, None], t.shape[:3] + (RET_DK,))

    qc, kc, vc, gc = prep(z_ctx)
    ql, kl, vl, gl = prep(z_lat)
    ql = _axial_rope(ql, rows_idx, cols_idx)
    kl = _axial_rope(kl, rows_idx, cols_idx)
    s0 = jnp.zeros((z_lat.shape[0], RET_HEADS, RET_DK, RET_DV), f32)
    oc_f, sf = _chunked_gla(qc, kc, vc, la(qc, 0), s0, False)
    oc_b, sb = _chunked_gla(qc, kc, vc, la(qc, 1), s0, True)
    ol_f, _ = _chunked_gla(ql, kl, vl, la(ql, 0), sf, False)
    ol_b, _ = _chunked_gla(ql, kl, vl, la(ql, 1), sb, True)
    return _gated_head_norm(oc_f + oc_b, gc, ln_g), _gated_head_norm(ol_f + ol_b, gl, ln_g)


def _gla(z_ctx, z_lat, a_up, a_b, ln_g):
    f32 = jnp.float32

    def prep(z):
        b_, l_, _ = z.shape
        q, k, v, g, alo = jnp.split(z, GLA_SPLITS, axis=-1)
        sh = (b_, l_, GLA_HEADS, GLA_DK)
        log_a = [(jax.nn.log_sigmoid((alo @ a_up[d] + a_b[d]).astype(f32)) / GLA_TAU).reshape(sh) for d in range(2)]
        return q.reshape(sh), k.reshape(sh) * GLA_DK ** -0.5, v.reshape(b_, l_, GLA_HEADS, GLA_DV), g, log_a

    qc, kc, vc, gc, lac = prep(z_ctx)
    ql, kl, vl, gl, lal = prep(z_lat)
    s0 = jnp.zeros((z_lat.shape[0], GLA_HEADS, GLA_DK, GLA_DV), f32)
    oc_f, sf = _chunked_gla(qc, kc, vc, lac[0], s0, False)
    oc_b, sb = _chunked_gla(qc, kc, vc, lac[1], s0, True)
    ol_f, _ = _chunked_gla(ql, kl, vl, lal[0], sf, False)
    ol_b, _ = _chunked_gla(ql, kl, vl, lal[1], sb, True)
    return _gated_head_norm(oc_f + oc_b, gc, ln_g), _gated_head_norm(ol_f + ol_b, gl, ln_g)


def _sq_relu_mlp(h, w1, w2):
    return jnp.square(jax.nn.relu(h @ w1)) @ w2


def setup_inputs(seed: int = 0) -> dict:
    key = jax.random.key(seed)
    keys = iter(jax.random.split(key, 64))
    f32 = jnp.float32

    def nrm(shape, scale):
        return jax.random.normal(next(keys), shape, f32) * scale

    n_idx = jnp.arange(S5_N, dtype=f32)
    gam = 1.0 - 2.0 ** (-5.0 - jnp.arange(RET_HEADS, dtype=f32))
    inp = {}
    inp['x'] = nrm((BATCH, SEQ, D_MODEL), 1.0)
    inp['c'] = nrm((BATCH, D_MODEL), 1.0)
    inp['ctx'] = nrm((BATCH, CTX_LEN, D_MODEL), 1.0)
    inp['c_ctx'] = nrm((D_MODEL,), 1.0)
    inp['ada_w'] = nrm((DEPTH, D_MODEL, N_ADA * D_MODEL), 0.5 * D_MODEL ** -0.5)
    inp['ada_b'] = nrm((DEPTH, N_ADA * D_MODEL), 0.02)
    inp['norm1_g'] = 1.0 + nrm((DEPTH, D_MODEL), 0.02)
    inp['norm2_g'] = 1.0 + nrm((DEPTH, D_MODEL), 0.02)
    inp['w_in'] = nrm((DEPTH, D_MODEL, IN_TOTAL), D_MODEL ** -0.5)
    inp['w_out'] = nrm((DEPTH, MIX_W, D_MODEL), MIX_W ** -0.5)
    inp['s5_lam_re'] = -0.5 + nrm((DEPTH, 2, S5_G, S5_N), 0.01)
    inp['s5_lam_im'] = math.pi * n_idx + nrm((DEPTH, 2, S5_G, S5_N), 0.01)
    inp['s5_log_dt'] = jax.random.uniform(next(keys), (DEPTH, 2, S5_G), f32, math.log(1e-3), math.log(1e-1))
    inp['s5_b_re'] = nrm((DEPTH, 2, S5_G, S5_N, S5_P), (2 * S5_P) ** -0.5)
    inp['s5_b_im'] = nrm((DEPTH, 2, S5_G, S5_N, S5_P), (2 * S5_P) ** -0.5)
    inp['s5_c_re'] = nrm((DEPTH, 2, S5_G, S5_P, S5_N), 0.5)
    inp['s5_c_im'] = nrm((DEPTH, 2, S5_G, S5_P, S5_N), 0.5)
    inp['s5_d'] = nrm((DEPTH, GROUP_W), 0.5)
    inp['s5_glu_w'] = nrm((DEPTH, GROUP_W, GROUP_W), GROUP_W ** -0.5)
    inp['s5_glu_b'] = nrm((DEPTH, GROUP_W), 0.02)
    inp['rw_mu'] = jax.random.uniform(next(keys), (DEPTH, RW_COLS), f32)
    inp['rw_w0'] = jnp.linspace(-6.5, -1.5, GROUP_W, dtype=f32) + nrm((DEPTH, 2, GROUP_W), 0.1)
    inp['rw_w_up'] = nrm((DEPTH, 2, RW_W_RANK, GROUP_W), 0.5 * RW_W_RANK ** -0.5)
    inp['rw_a0'] = nrm((DEPTH, 2, GROUP_W), 0.1)
    inp['rw_a_up'] = nrm((DEPTH, 2, RW_A_RANK, GROUP_W), 0.5 * RW_A_RANK ** -0.5)
    inp['rw_g_up'] = nrm((DEPTH, RW_G_RANK, GROUP_W), RW_G_RANK ** -0.5)
    inp['rw_k_k'] = 0.85 + nrm((DEPTH, GROUP_W), 0.02)
    inp['rw_k_a'] = 1.0 + nrm((DEPTH, GROUP_W), 0.02)
    inp['rw_r_k'] = nrm((DEPTH, RW_HEADS, RW_HEAD), 0.1)
    inp['rw_ln_g'] = 1.0 + nrm((DEPTH, GROUP_W), 0.02)
    inp['rw_ln_b'] = nrm((DEPTH, GROUP_W), 0.02)
    inp['ret_decay_logit'] = jnp.log(gam / (1.0 - gam)) + nrm((DEPTH, 2, RET_HEADS), 0.05)
    inp['ret_ln_g'] = 1.0 + nrm((DEPTH, GROUP_W), 0.02)
    inp['gla_a_up'] = nrm((DEPTH, 2, GLA_RANK, GLA_QK), GLA_RANK ** -0.5)
    inp['gla_a_b'] = 1.0 + nrm((DEPTH, 2, GLA_QK), 0.5)
    inp['gla_ln_g'] = 1.0 + nrm((DEPTH, GROUP_W), 0.02)
    inp['mlp_w1'] = nrm((DEPTH, D_MODEL, D_FF), D_MODEL ** -0.5)
    inp['mlp_w2'] = nrm((DEPTH, D_FF, D_MODEL), D_FF ** -0.5)
    inp['final_g'] = 1.0 + nrm((D_MODEL,), 0.02)
    return inp


def reference(x, c, ctx, c_ctx, ada_w, ada_b, norm1_g, norm2_g, w_in, w_out,
              s5_lam_re, s5_lam_im, s5_log_dt, s5_b_re, s5_b_im, s5_c_re, s5_c_im, s5_d, s5_glu_w, s5_glu_b,
              rw_mu, rw_w0, rw_w_up, rw_a0, rw_a_up, rw_g_up, rw_k_k, rw_k_a, rw_r_k, rw_ln_g, rw_ln_b,
              ret_decay_logit, ret_ln_g, gla_a_up, gla_a_b, gla_ln_g, mlp_w1, mlp_w2, final_g):
    l_ = x.shape[1]
    rows = l_ // GRID_W
    rows_idx = jnp.repeat(jnp.arange(rows, dtype=jnp.int32), GRID_W)
    cols_idx = jnp.tile(jnp.arange(GRID_W, dtype=jnp.int32), rows)
    cond_lat = jax.nn.silu(c)
    cond_ctx = jax.nn.silu(c_ctx)[None]
    xc = ctx
    for i in range(DEPTH):
        last = i == DEPTH - 1
        mod_l = (cond_lat @ ada_w[i] + ada_b[i])[:, None, :]
        mod_c = (cond_ctx @ ada_w[i] + ada_b[i])[:, None, :]
        sh1, sc1, g1, sh2, sc2, g2 = jnp.split(mod_l, N_ADA, axis=-1)
        sh1c, sc1c, g1c, sh2c, sc2c, g2c = jnp.split(mod_c, N_ADA, axis=-1)

        h_l = _rmsnorm(x, norm1_g[i]) * (1.0 + sc1) + sh1
        h_c = _rmsnorm(xc, norm1_g[i]) * (1.0 + sc1c) + sh1c
        z_l = h_l @ w_in[i]
        z_c = h_c @ w_in[i]
        s5_l, rw_l, ret_l, gla_l = jnp.split(z_l, IN_SPLITS, axis=-1)
        s5_c, rw_c, ret_c, gla_c = jnp.split(z_c, IN_SPLITS, axis=-1)

        ya_c, ya_l = _s5(s5_c, s5_l, s5_lam_re[i], s5_lam_im[i], s5_log_dt[i], s5_b_re[i], s5_b_im[i],
                         s5_c_re[i], s5_c_im[i], s5_d[i], s5_glu_w[i], s5_glu_b[i])
        yb_c, yb_l = _rwkv7(rw_c, rw_l, rows, rw_mu[i], rw_w0[i], rw_w_up[i], rw_a0[i], rw_a_up[i], rw_g_up[i],
                            rw_k_k[i], rw_k_a[i], rw_r_k[i], rw_ln_g[i], rw_ln_b[i])
        yc_c, yc_l = _retention(ret_c, ret_l, rows_idx, cols_idx, ret_decay_logit[i], ret_ln_g[i])
        yd_c, yd_l = _gla(gla_c, gla_l, gla_a_up[i], gla_a_b[i], gla_ln_g[i])

        mix_l = jnp.concatenate([ya_l, yb_l, yc_l, yd_l], axis=-1) @ w_out[i]
        x = x + g1 * mix_l
        h_l = _rmsnorm(x, norm2_g[i]) * (1.0 + sc2) + sh2
        x = x + g2 * _sq_relu_mlp(h_l, mlp_w1[i], mlp_w2[i])

        if not last:
            mix_c = jnp.concatenate([ya_c, yb_c, yc_c, yd_c], axis=-1) @ w_out[i]
            xc = xc + g1c * mix_c
            h_c = _rmsnorm(xc, norm2_g[i]) * (1.0 + sc2c) + sh2c
            xc = xc + g2c * _sq_relu_mlp(h_c, mlp_w1[i], mlp_w2[i])
    return _rmsnorm(x, final_g)
```

```cpp
#include <hip/hip_runtime.h>
#include <hip/hip_cooperative_groups.h>
#include <cstdio>
namespace cg = cooperative_groups;
namespace pg8 {
#define PG8_LAS __attribute__((address_space(3)))
typedef unsigned short bf16_t;
typedef short bf16x8 __attribute__((ext_vector_type(8)));
typedef float f32x4 __attribute__((ext_vector_type(4)));
typedef unsigned u32x4 __attribute__((ext_vector_type(4)));
constexpr int BM = 256, BK = 64, HALF = 128, HTB = HALF * BK * 2  , STAGE_BYTES = 8 * HTB, NXCD = 8, WGM = 8;

__host__ __device__ __forceinline__ int lds_byte(int r, int c) { const int st = (r >> 4) * 2 + (c >> 5), rr = r & 15, cc = c & 31, ob = rr * 64 + cc * 2; return st * 1024 + (ob ^ (((ob >> 9) & 1) << 5)); }
__host__ __device__ __forceinline__ void stage_rc(int b, int& R, int& C) { const int st = b / 1024, sb = b % 1024, swz = sb ^ (((sb >> 9) & 1) << 5); R = (st >> 1) * 16 + swz / 64; C = (st & 1) * 32 + (swz % 64) / 2; }
__host__ __device__ __forceinline__ int perm32(int rho) { const int n = rho >> 4, i = rho & 15; return 8 * (i >> 2) + 4 * n + (i & 3); }

struct Unit { int pm, pn; };
struct Gemm { const bf16_t* A; const bf16_t* Bt; int M, N, K; };

struct StaticOrder {
    int nM, nN, nwg, G, c;
    __host__ __device__ void init(int M, int N, int G_, int c_) { nM = M / BM; nN = N / BM; nwg = nM * nN; G = G_; c = c_; }
    __host__ __device__ bool next(int i, Unit& u) const {
        const long L = (long)i * G + c; if (L >= nwg) return false;
        int wgid = (int)L; { const int q = nwg / NXCD, r = nwg % NXCD, xcd = wgid % NXCD, off = wgid / NXCD; wgid = (xcd < r ? xcd * (q + 1) : r * (q + 1) + (xcd - r) * q) + off; }
        const int nig = WGM * nN, gid = wgid / nig, fm = gid * WGM, gsz = (nM - fm) < WGM ? (nM - fm) : WGM;
        u.pm = fm + ((wgid % nig) % gsz); u.pn = (wgid % nig) / gsz; return true;
    }
    __device__ __forceinline__ void a_ready(const Unit&) const {}
    __device__ __forceinline__ void done(const Unit&) const {}
};
__device__ __forceinline__ unsigned cvt_pk_bf16(float lo, float hi) { unsigned r; asm volatile("v_cvt_pk_bf16_f32 %0, %1, %2" : "=v"(r) : "v"(lo), "v"(hi)); return r; }
template <class Epi, class Sched, bool STAMP = false>
__device__ __forceinline__ void gemm_phase(PG8_LAS unsigned char* lds, const Gemm g, const Sched& S, const Epi& E, unsigned long long* stamps) {
    int tid = threadIdx.x; asm volatile("" : "+v"(tid)); const int wid = __builtin_amdgcn_readfirstlane(tid >> 6), lane = tid & 63, wr = wid >> 2, wc = wid & 3, fr = lane & 15, fq = lane >> 4;
    const int K = g.K, nt = K / BK;
    int ts_lo = 0, ts_hi = 0, nts = 0; const unsigned long long rt_entry = STAMP ? (unsigned long long)wall_clock64() : 0ull;
#define PG8_STAMP() do { if (STAMP && wid == 0 && nts < 64) { const unsigned long long _c = (unsigned long long)clock64(); \
        ts_lo = (lane == nts) ? (int)(unsigned)_c : ts_lo; ts_hi = (lane == nts) ? (int)(unsigned)(_c >> 32) : ts_hi; ++nts; } } while (0)
    PG8_STAMP();
    unsigned voffA[2], voffB[2];
#pragma unroll
    for (int i = 0; i < 2; ++i) { int R, C; stage_rc(tid * 16 + i * 8192, R, C); const int Rb = Epi::PERM ? ((R & ~31) + perm32(R & 31)) : R;
        voffA[i] = (unsigned)(R * K + C) * 2u; voffB[i] = (unsigned)(Rb * K + C) * 2u; }
    const size_t kstep = (size_t)(BK * 2);
    const size_t hstep = (size_t)HALF * K * 2;
    const size_t tstep = 2 * hstep;
    const unsigned ldsw = (unsigned)wid * 1024u;
    const int aoff = lds_byte(wr * 64 + fr, fq * 8), boff = lds_byte(wc * 32 + fr, fq * 8);
#define PG8_SA(b, h) (((b) * 2 + (h)) * HTB)
#define PG8_SB(b, h) ((4 + (b) * 2 + (h)) * HTB)
#define PG8_STAGE(bufoff, gbase, voff) do { _Pragma("unroll") for (int _i = 0; _i < 2; ++_i) \
        __builtin_amdgcn_global_load_lds((const unsigned*)((const char*)(gbase) + (voff)[_i]), (PG8_LAS unsigned*)(lds + (bufoff) + ldsw + _i * 8192), 16, 0, 0); } while (0)
#define PG8_LDA(dst, b, h) do { _Pragma("unroll") for (int m = 0; m < 4; ++m) _Pragma("unroll") for (int k = 0; k < 2; ++k) dst[m][k] = *(const PG8_LAS bf16x8*)(lds + PG8_SA(b, h) + aoff + m * 2048 + k * 1024); } while (0)
#define PG8_LDB(dst, b, h) do { _Pragma("unroll") for (int n = 0; n < 2; ++n) _Pragma("unroll") for (int k = 0; k < 2; ++k) dst[n][k] = *(const PG8_LAS bf16x8*)(lds + PG8_SB(b, h) + boff + n * 2048 + k * 1024); } while (0)
#define PG8_MMA(ai, bj, At, Bt) do { __builtin_amdgcn_s_setprio(1); _Pragma("unroll") for (int m = 0; m < 4; ++m) _Pragma("unroll") for (int n = 0; n < 2; ++n) _Pragma("unroll") for (int k = 0; k < 2; ++k) \
        acc[ai][bj][m][n] = __builtin_amdgcn_mfma_f32_16x16x32_bf16(Bt[n][k], At[m][k], acc[ai][bj][m][n], 0, 0, 0); __builtin_amdgcn_s_setprio(0); } while (0)
#define PG8_WAIT_V(n) asm volatile("s_waitcnt vmcnt(" #n ")" ::: "memory")
#define PG8_WAIT_L(n) asm volatile("s_waitcnt lgkmcnt(" #n ")" ::: "memory")
#define PG8_BAR __builtin_amdgcn_s_barrier()
#define PG8_SCHED __builtin_amdgcn_sched_barrier(0)
    Unit cur, nxt; int ui = 0;
    if (!S.next(0, cur)) return;
    f32x4 acc[2][2][4][2];
#pragma unroll
    for (int a = 0; a < 2; ++a)
#pragma unroll
        for (int b = 0; b < 2; ++b)
#pragma unroll
            for (int m = 0; m < 4; ++m)
#pragma unroll
                for (int n = 0; n < 2; ++n) acc[a][b][m][n] = (f32x4){0.f, 0.f, 0.f, 0.f};
    bf16x8 At[4][2], B0[2][2], B1[2][2];
    const char* cA = (const char*)g.A + (size_t)cur.pm * tstep; const char* cB = (const char*)g.Bt + (size_t)cur.pn * tstep;
    S.a_ready(cur);
    PG8_STAGE(PG8_SB(0, 0), cB, voffB); PG8_STAGE(PG8_SA(0, 0), cA, voffA); PG8_STAGE(PG8_SB(0, 1), cB + hstep, voffB); PG8_STAGE(PG8_SA(0, 1), cA + hstep, voffA);
    if (wr == 1) PG8_BAR;
    PG8_WAIT_V(4); PG8_BAR;
    PG8_STAGE(PG8_SB(1, 0), cB + kstep, voffB); PG8_STAGE(PG8_SA(1, 0), cA + kstep, voffA); PG8_STAGE(PG8_SB(1, 1), cB + hstep + kstep, voffB);
    PG8_WAIT_V(6); PG8_BAR;
    PG8_STAMP();
    for (;;) {
        const bool has_next = S.next(ui + 1, nxt);
        const char* nA = has_next ? (const char*)g.A + (size_t)nxt.pm * tstep : cA; const char* nB = has_next ? (const char*)g.Bt + (size_t)nxt.pn * tstep : cB;
        for (int t = 0; t < nt; t += 2) {
            const bool last = (t == nt - 2);
            const char* a1 = cA + (size_t)(t + 1) * kstep;
            const char* a2 = last ? nA : cA + (size_t)(t + 2) * kstep; const char* b2 = last ? nB : cB + (size_t)(t + 2) * kstep;
            const char* a3 = a2 + kstep; const char* b3 = b2 + kstep;
            if (last && has_next) S.a_ready(nxt);
            PG8_LDB(B0, 0, 0); PG8_SCHED; PG8_LDA(At, 0, 0); PG8_STAGE(PG8_SA(1, 1), a1 + hstep, voffA);
            PG8_WAIT_L(8); PG8_BAR; PG8_WAIT_L(0); PG8_MMA(0, 0, At, B0); PG8_BAR; PG8_SCHED;
            PG8_LDB(B1, 0, 1); PG8_STAGE(PG8_SB(0, 0), b2, voffB);
            PG8_BAR; PG8_WAIT_L(0); PG8_MMA(0, 1, At, B1); PG8_BAR;
            PG8_LDA(At, 0, 1); PG8_STAGE(PG8_SA(0, 0), a2, voffA);
            PG8_BAR; PG8_WAIT_L(0); PG8_MMA(1, 0, At, B0); PG8_BAR; PG8_SCHED;
            PG8_STAGE(PG8_SB(0, 1), b2 + hstep, voffB);
            PG8_WAIT_V(6); PG8_BAR; PG8_MMA(1, 1, At, B1); PG8_BAR;
            PG8_LDB(B0, 1, 0); PG8_SCHED; PG8_LDA(At, 1, 0); PG8_STAGE(PG8_SA(0, 1), a2 + hstep, voffA);
            PG8_WAIT_L(8); PG8_BAR; PG8_WAIT_L(0); PG8_MMA(0, 0, At, B0); PG8_BAR; PG8_SCHED;
            PG8_LDB(B1, 1, 1); PG8_STAGE(PG8_SB(1, 0), b3, voffB);
            PG8_BAR; PG8_WAIT_L(0); PG8_MMA(0, 1, At, B1); PG8_BAR;
            PG8_LDA(At, 1, 1); PG8_STAGE(PG8_SA(1, 0), a3, voffA);
            PG8_BAR; PG8_WAIT_L(0); PG8_MMA(1, 0, At, B0); PG8_BAR; PG8_SCHED;
            PG8_STAGE(PG8_SB(1, 1), b3 + hstep, voffB);
            PG8_WAIT_V(6); PG8_BAR; PG8_MMA(1, 1, At, B1); PG8_BAR;
        }
        PG8_STAMP();
        if constexpr (!Epi::AFTER_DRAIN) { E(acc, cur, wr, wc, fr, fq); S.done(cur); }
        PG8_STAMP();
        if (!has_next) break;
#pragma unroll
        for (int a = 0; a < 2; ++a)
#pragma unroll
            for (int b = 0; b < 2; ++b)
#pragma unroll
                for (int m = 0; m < 4; ++m)
#pragma unroll
                    for (int n = 0; n < 2; ++n) acc[a][b][m][n] = (f32x4){0.f, 0.f, 0.f, 0.f};
        cur = nxt; cA = nA; cB = nB; ++ui;
    }
    PG8_WAIT_V(0);
    if (wr == 0) PG8_BAR;
    PG8_BAR;
    if constexpr (Epi::AFTER_DRAIN) { E.fused(acc, cur, wr, wc, fr, fq, lds, wid, lane); S.done(cur); }
    PG8_STAMP();
    if (STAMP && wid == 0) { stamps[lane] = lane < nts ? (((unsigned long long)(unsigned)ts_hi << 32) | (unsigned)ts_lo) : 0ull;
        if (lane == 62) stamps[62] = rt_entry; if (lane == 63) stamps[63] = (unsigned long long)wall_clock64(); }
#undef PG8_STAMP
#undef PG8_SA
#undef PG8_SB
#undef PG8_STAGE
#undef PG8_LDA
#undef PG8_LDB
#undef PG8_MMA
#undef PG8_WAIT_V
#undef PG8_WAIT_L
#undef PG8_BAR
#undef PG8_SCHED
}
}
using pg8::bf16_t; using pg8::bf16x8; using pg8::f32x4; using pg8::u32x4;
#define DI __device__ __forceinline__
#ifndef DBG_ONLY
#define DBG_ONLY -1
#endif
#define PH_EN(x) (DBG_ONLY < 0 || DBG_ONLY == (x))
#ifndef MULTI_LAUNCH
#define MULTI_LAUNCH 0
#endif

enum { I_X = 0, I_C, I_CTX, I_CCTX, I_ADAW, I_ADAB, I_N1G, I_N2G, I_WIN, I_WOUT,
       I_S5LRE, I_S5LIM, I_S5LDT, I_S5BRE, I_S5BIM, I_S5CRE, I_S5CIM, I_S5D, I_S5GW, I_S5GB,
       I_RWMU, I_RWW0, I_RWWUP, I_RWA0, I_RWAUP, I_RWGUP, I_RWKK, I_RWKA, I_RWRK, I_RWLNG, I_RWLNB,
       I_RETDEC, I_RETLNG, I_GLAAUP, I_GLAAB, I_GLALNG, I_W1, I_W2, I_FING, N_IN };

struct Params { const float* in[N_IN]; float* out; unsigned char* ws; int ph_lo, ph_hi; };

constexpr int D = 1024, NB = 2, SEQ = 16384, CTXL = 256;
constexpr int NLAT = NB * SEQ, NROW = NLAT + NB * CTXL;
constexpr int ZLD = 2960, ZPAD = 3072, DFF = 4096, NCH = 260;
constexpr int Z_RW = 256, Z_RET = 1152, Z_GLA = 2176;
constexpr int LDS_BYTES = 144 * 1024;
constexpr int NPHASE = 38;

constexpr size_t al256(size_t x) { return (x + 255) & ~(size_t)255; }
constexpr size_t WS_MOD   = 0;
constexpr size_t WS_S5A   = al256(WS_MOD + (size_t)4 * 3 * 6144 * 4);
constexpr size_t WS_S5B   = al256(WS_S5A + (size_t)4 * 2 * 16 * 64 * 2 * 4);
constexpr size_t WS_XCTX  = al256(WS_S5B + (size_t)4 * 2 * 16 * 64 * 16 * 2 * 4);
constexpr size_t WS_WTIN  = al256(WS_XCTX + (size_t)512 * 1024 * 4);
constexpr size_t WS_WTOUT = al256(WS_WTIN + (size_t)ZPAD * 1024 * 2);
constexpr size_t WS_WT1   = al256(WS_WTOUT + (size_t)1024 * 1024 * 2);
constexpr size_t WS_WT2   = al256(WS_WT1 + (size_t)4096 * 1024 * 2);
constexpr size_t WS_WTGLU = al256(WS_WT2 + (size_t)4096 * 1024 * 2);
constexpr size_t WS_H     = al256(WS_WTGLU + (size_t)256 * 256 * 2);
constexpr size_t WS_S5E   = al256(WS_H + (size_t)NROW * 1024 * 2);
constexpr size_t WS_DECR  = al256(WS_S5E + (size_t)2 * 2 * 16 * NCH * 64 * 2 * 4);
constexpr size_t WS_DECG  = al256(WS_DECR + (size_t)16 * NCH * 64 * 4);
constexpr size_t WS_CSR   = al256(WS_DECG + (size_t)16 * NCH * 32 * 4);
constexpr size_t WS_CSG   = al256(WS_CSR + (size_t)16 * NCH * 64 * 64 * 2);
constexpr size_t WS_Z     = al256(WS_CSG + (size_t)16 * NCH * 64 * 32 * 2);
constexpr size_t WS_RWOP  = al256(WS_Z + (size_t)NROW * ZLD * 2);
constexpr size_t WS_END   = al256(WS_RWOP + (size_t)9 * NROW * 256 * 2);
constexpr size_t WS_HID   = WS_Z;
static_assert((size_t)NROW * DFF * 2 <= WS_END - WS_Z, "hidden alias");
constexpr size_t RWOP_STRIDE = (size_t)NROW * 256;
enum { RW_R = 0, RW_K, RW_V, RW_KK, RW_AS0, RW_AS1, RW_OM0, RW_OM1, RW_G };

DI int otid() { int t = threadIdx.x; asm volatile("" : "+v"(t)); return t; }
DI float bf2f(bf16_t b) { return __uint_as_float(((unsigned)b) << 16); }
DI bf16_t f2bf(float f) { unsigned u = __float_as_uint(f); u += 0x7FFFu + ((u >> 16) & 1u); return (bf16_t)(u >> 16); }
DI unsigned pk2(float lo, float hi) { return (unsigned)f2bf(lo) | ((unsigned)f2bf(hi) << 16); }
DI float wave_sum(float v) {
#pragma unroll
    for (int o = 1; o < 64; o <<= 1) v += __shfl_xor(v, o);
    return v;
}
DI float sigmoid_(float x) { return 1.f / (1.f + __expf(-x)); }
DI float softplus_(float x) { return fmaxf(x, 0.f) + log1pf(__expf(-fabsf(x))); }
DI float logsigmoid_(float x) { return -softplus_(-x); }
DI float silu_(float x) { return x * sigmoid_(x); }
DI float gelu_tanh_(float x) { const float u = 0.7978845608028654f * (x + 0.044715f * x * x * x); return 0.5f * x * (1.f + tanhf(u)); }
#define WAVE_LDS_SYNC() asm volatile("s_waitcnt lgkmcnt(0)" ::: "memory")

DI float* xrow(const Params& p, int row) { return row < NLAT ? p.out + (size_t)row * D : (float*)(p.ws + WS_XCTX) + (size_t)(row - NLAT) * D; }
DI int chunk_row0(int b, int ci) { return ci < 4 ? NLAT + b * CTXL + ci * 64 : b * SEQ + (ci - 4) * 64; }
DI int chunk_at(int dir, int pos) { return dir == 0 ? pos : (pos < 4 ? 3 - pos : 263 - pos); }
DI int modset(int row) { return row < SEQ ? 0 : (row < NLAT ? 1 : 2); }

struct EpiZ {
    static constexpr bool PERM = true, AFTER_DRAIN = false;
    bf16_t* O;
    DI void operator()(const f32x4 (&acc)[2][2][4][2], const pg8::Unit& u, int wr, int wc, int fr, int fq) const {
        const int row0 = u.pm * 256 + wr * 64 + fr, col0 = u.pn * 256 + wc * 32 + 8 * fq;
#pragma unroll
        for (int ai = 0; ai < 2; ++ai)
#pragma unroll
            for (int m = 0; m < 4; ++m) { bf16_t* rowp = O + (size_t)(row0 + ai * 128 + m * 16) * ZLD + col0;
#pragma unroll
                for (int bj = 0; bj < 2; ++bj) { if (col0 + bj * 128 < ZLD) { const f32x4 v0 = acc[ai][bj][m][0], v1 = acc[ai][bj][m][1];
                    u32x4 w; w.x = pg8::cvt_pk_bf16(v0[0], v0[1]); w.y = pg8::cvt_pk_bf16(v0[2], v0[3]); w.z = pg8::cvt_pk_bf16(v1[0], v1[1]); w.w = pg8::cvt_pk_bf16(v1[2], v1[3]);
                    *(u32x4*)(rowp + bj * 128) = w; } } }
    }
};
struct EpiSq {
    static constexpr bool PERM = true, AFTER_DRAIN = false;
    bf16_t* O;
    DI void operator()(const f32x4 (&acc)[2][2][4][2], const pg8::Unit& u, int wr, int wc, int fr, int fq) const {
        const int row0 = u.pm * 256 + wr * 64 + fr, col0 = u.pn * 256 + wc * 32 + 8 * fq;
#pragma unroll
        for (int ai = 0; ai < 2; ++ai)
#pragma unroll
            for (int m = 0; m < 4; ++m) { bf16_t* rowp = O + (size_t)(row0 + ai * 128 + m * 16) * DFF + col0;
#pragma unroll
                for (int bj = 0; bj < 2; ++bj) { f32x4 v0 = acc[ai][bj][m][0], v1 = acc[ai][bj][m][1];
#pragma unroll
                    for (int j = 0; j < 4; ++j) { const float a = fmaxf(v0[j], 0.f), b = fmaxf(v1[j], 0.f); v0[j] = a * a; v1[j] = b * b; }
                    u32x4 w; w.x = pg8::cvt_pk_bf16(v0[0], v0[1]); w.y = pg8::cvt_pk_bf16(v0[2], v0[3]); w.z = pg8::cvt_pk_bf16(v1[0], v1[1]); w.w = pg8::cvt_pk_bf16(v1[2], v1[3]);
                    *(u32x4*)(rowp + bj * 128) = w; } }
    }
};
struct EpiRes {
    static constexpr bool PERM = false, AFTER_DRAIN = false;
    float* out; float* xctx; const float* gate;
    DI void operator()(const f32x4 (&acc)[2][2][4][2], const pg8::Unit& u, int wr, int wc, int fr, int fq) const {
        const int row0 = u.pm * 256 + wr * 64 + fr, col0 = u.pn * 256 + wc * 32 + 4 * fq;
        const int set = u.pm < 64 ? 0 : (u.pm < 128 ? 1 : 2);
        const float* gp = gate + set * 6144 + col0;
        f32x4 gv[2][2];
#pragma unroll
        for (int bj = 0; bj < 2; ++bj)
#pragma unroll
            for (int n = 0; n < 2; ++n) gv[bj][n] = *(const f32x4*)(gp + bj * 128 + n * 16);
#pragma unroll
        for (int ai = 0; ai < 2; ++ai)
#pragma unroll
            for (int m = 0; m < 4; ++m) { const int row = row0 + ai * 128 + m * 16;
                float* xr = (row < NLAT ? out + (size_t)row * D : xctx + (size_t)(row - NLAT) * D) + col0;
#pragma unroll
                for (int bj = 0; bj < 2; ++bj)
#pragma unroll
                    for (int n = 0; n < 2; ++n) { f32x4* px = (f32x4*)(xr + bj * 128 + n * 16); f32x4 xv = *px; xv = xv + gv[bj][n] * acc[ai][bj][m][n]; *px = xv; } }
    }
};
template <class Epi> DI void run_gemm(const bf16_t* A, const bf16_t* Bt, int N, int K, const Epi& E, PG8_LAS unsigned char* lds) {
    pg8::Gemm g{A, Bt, NROW, N, K}; pg8::StaticOrder S; S.init(NROW, N, (int)gridDim.x, (int)blockIdx.x);
    pg8::gemm_phase<Epi, pg8::StaticOrder, false>(lds, g, S, E, nullptr);
}

DI void phase_pre(const Params& p, unsigned char* lds) {
    const int tid = otid(); const size_t nthr = (size_t)gridDim.x * 512, gtid = (size_t)blockIdx.x * 512 + tid;
    { const float4* s = (const float4*)p.in[I_X]; float4* d = (float4*)p.out; for (size_t i = gtid; i < (size_t)NLAT * D / 4; i += nthr) d[i] = s[i];
      const float4* s2 = (const float4*)p.in[I_CTX]; float4* d2 = (float4*)(p.ws + WS_XCTX); for (size_t i = gtid; i < (size_t)512 * D / 4; i += nthr) d2[i] = s2[i]; }
    { float* abar = (float*)(p.ws + WS_S5A); float* bbar = (float*)(p.ws + WS_S5B);
      for (size_t e = gtid; e < (size_t)4 * 2 * 16 * 64; e += nthr) {
        const float lr = fminf(p.in[I_S5LRE][e], -1e-4f), li = p.in[I_S5LIM][e], dt = expf(p.in[I_S5LDT][e >> 6]);
        const float th = li * dt; float sn, cs; sincosf(th, &sn, &cs); const float em = expm1f(lr * dt), sh = sinf(0.5f * th);
        const float ar = (em + 1.f) * cs, ai = (em + 1.f) * sn; const float nr = em * cs - 2.f * sh * sh, ni = ai;
        const float den = 1.f / (lr * lr + li * li); const float qr = (nr * lr + ni * li) * den, qi = (ni * lr - nr * li) * den;
        abar[e * 2] = ar; abar[e * 2 + 1] = ai;
        for (int pp = 0; pp < 16; ++pp) { const float br = p.in[I_S5BRE][e * 16 + pp], bi = p.in[I_S5BIM][e * 16 + pp];
            bbar[(e * 16 + pp) * 2] = qr * br - qi * bi; bbar[(e * 16 + pp) * 2 + 1] = qr * bi + qi * br; } } }
    float* cond = (float*)lds; float* red = cond + 3 * 1024; float* mod = (float*)(p.ws + WS_MOD);
    for (int i = tid; i < 3072; i += 512) { const int set = i >> 10, k = i & 1023; const float cv = set < 2 ? p.in[I_C][set * 1024 + k] : p.in[I_CCTX][k]; cond[i] = silu_(cv); }
    __syncthreads();
    for (int item = blockIdx.x; item < 384; item += gridDim.x) {
        const int layer = item / 96, cb = item % 96, ks = tid >> 6, c = tid & 63;
        const float* W = p.in[I_ADAW] + (size_t)layer * 1024 * 6144 + cb * 64 + c;
        float a0 = 0.f, a1 = 0.f, a2 = 0.f;
#pragma unroll 8
        for (int k = ks * 128; k < ks * 128 + 128; ++k) { const float w = W[(size_t)k * 6144]; a0 += cond[k] * w; a1 += cond[1024 + k] * w; a2 += cond[2048 + k] * w; }
        red[(ks * 3 + 0) * 64 + c] = a0; red[(ks * 3 + 1) * 64 + c] = a1; red[(ks * 3 + 2) * 64 + c] = a2;
        __syncthreads();
        if (tid < 192) { const int set = tid >> 6, cc = tid & 63; float s = p.in[I_ADAB][layer * 6144 + cb * 64 + cc];
            for (int q = 0; q < 8; ++q) s += red[(q * 3 + set) * 64 + cc];
            mod[(size_t)(layer * 3 + set) * 6144 + cb * 64 + cc] = s; }
        __syncthreads();
    }
}

DI void transpose_item(const float* W, int K, int N, int Npad, bf16_t* WT, float* scr, int item, int lane) {
    const int nblk = Npad / 32, kb = item / nblk, nb = item % nblk, k0 = 64 * kb, n0 = 32 * nb;
    const int n = n0 + (lane & 31);
#pragma unroll 8
    for (int i = 0; i < 32; ++i) { const int kk = 2 * i + (lane >> 5); scr[kk * 33 + (lane & 31)] = n < N ? W[(size_t)(k0 + kk) * N + n] : 0.f; }
    WAVE_LDS_SYNC();
    const int c = lane & 7;
#pragma unroll
    for (int j = 0; j < 4; ++j) { const int nn = (lane >> 3) + 8 * j; const float* s = scr + (8 * c) * 33 + nn;
        u32x4 o; o.x = pk2(s[0 * 33], s[1 * 33]); o.y = pk2(s[2 * 33], s[3 * 33]); o.z = pk2(s[4 * 33], s[5 * 33]); o.w = pk2(s[6 * 33], s[7 * 33]);
        *(u32x4*)(WT + (size_t)(n0 + nn) * K + k0 + 8 * c) = o; }
    WAVE_LDS_SYNC();
}
DI void phase_norm(const Params& p, int layer, int which, unsigned char* lds) {
    const int tid = otid(), wave = tid >> 6, lane = tid & 63, gw = blockIdx.x * 8 + wave, NGW = gridDim.x * 8;
    if (which == 0) {
        float* scr = (float*)(lds + wave * 8704);
        constexpr int I_IN = 16 * 96, I_OUT = 16 * 32, I_1 = 16 * 128, I_2 = 64 * 32, I_G = 4 * 8;
        for (int it = gw; it < I_IN + I_OUT + I_1 + I_2 + I_G; it += NGW) {
            int r = it;
            if (r < I_IN) { transpose_item(p.in[I_WIN] + (size_t)layer * 1024 * ZLD, 1024, ZLD, ZPAD, (bf16_t*)(p.ws + WS_WTIN), scr, r, lane); continue; } r -= I_IN;
            if (r < I_OUT) { transpose_item(p.in[I_WOUT] + (size_t)layer * 1024 * 1024, 1024, 1024, 1024, (bf16_t*)(p.ws + WS_WTOUT), scr, r, lane); continue; } r -= I_OUT;
            if (r < I_1) { transpose_item(p.in[I_W1] + (size_t)layer * 1024 * 4096, 1024, 4096, 4096, (bf16_t*)(p.ws + WS_WT1), scr, r, lane); continue; } r -= I_1;
            if (r < I_2) { transpose_item(p.in[I_W2] + (size_t)layer * 4096 * 1024, 4096, 1024, 1024, (bf16_t*)(p.ws + WS_WT2), scr, r, lane); continue; } r -= I_2;
            transpose_item(p.in[I_S5GW] + (size_t)layer * 256 * 256, 256, 256, 256, (bf16_t*)(p.ws + WS_WTGLU), scr, r, lane);
        }
    }
    const float* gam = p.in[which == 0 ? I_N1G : I_N2G] + layer * 1024;
    const float* modl = (const float*)(p.ws + WS_MOD) + (size_t)layer * 3 * 6144 + (which == 0 ? 0 : 3072);
    bf16_t* H = (bf16_t*)(p.ws + WS_H);
    for (int row = gw; row < NROW; row += NGW) {
        const float* xr = xrow(p, row); const float* sh = modl + modset(row) * 6144; const float* sc = sh + 1024;
        float4 v[4]; float ss = 0.f;
#pragma unroll
        for (int j = 0; j < 4; ++j) { v[j] = *(const float4*)(xr + 4 * lane + 256 * j); ss += v[j].x * v[j].x + v[j].y * v[j].y + v[j].z * v[j].z + v[j].w * v[j].w; }
        const float rstd = rsqrtf(wave_sum(ss) * (1.f / 1024.f) + 1e-6f);
#pragma unroll
        for (int j = 0; j < 4; ++j) { const int c = 4 * lane + 256 * j; const float4 g = *(const float4*)(gam + c), s1 = *(const float4*)(sc + c), s0 = *(const float4*)(sh + c);
            const float o0 = v[j].x * rstd * g.x * (1.f + s1.x) + s0.x, o1 = v[j].y * rstd * g.y * (1.f + s1.y) + s0.y, o2 = v[j].z * rstd * g.z * (1.f + s1.z) + s0.z, o3 = v[j].w * rstd * g.w * (1.f + s1.w) + s0.w;
            uint2 w; w.x = pk2(o0, o1); w.y = pk2(o2, o3); *(uint2*)(H + (size_t)row * D + c) = w; }
    }
}
DI void phase_final(const Params& p) {
    const int tid = otid(), wave = tid >> 6, lane = tid & 63, gw = blockIdx.x * 8 + wave, NGW = gridDim.x * 8;
    const float* gam = p.in[I_FING];
    for (int row = gw; row < NLAT; row += NGW) {
        float* xr = p.out + (size_t)row * D; float4 v[4]; float ss = 0.f;
#pragma unroll
        for (int j = 0; j < 4; ++j) { v[j] = *(const float4*)(xr + 4 * lane + 256 * j); ss += v[j].x * v[j].x + v[j].y * v[j].y + v[j].z * v[j].z + v[j].w * v[j].w; }
        const float rstd = rsqrtf(wave_sum(ss) * (1.f / 1024.f) + 1e-6f);
#pragma unroll
        for (int j = 0; j < 4; ++j) { const int c = 4 * lane + 256 * j; const float4 g = *(const float4*)(gam + c);
            float4 o; o.x = v[j].x * rstd * g.x; o.y = v[j].y * rstd * g.y; o.z = v[j].z * rstd * g.z; o.w = v[j].w * rstd * g.w; *(float4*)(xr + c) = o; }
    }
}

DI void rwkv_prep_item(const Params& p, int layer, int item, unsigned char* lds) {
    const int tid = otid(), row0 = item * 8;
    float* zm = (float*)lds;
    float* tw = zm + 8 * 896;
    float* sg = tw + 8 * 32;
    const bf16_t* Z = (const bf16_t*)(p.ws + WS_Z);
    const float* mu = p.in[I_RWMU] + layer * 896;
    for (int idx = tid; idx < 8 * 896; idx += 512) {
        const int rr = idx / 896, c = idx % 896, row = row0 + rr; int nrow = -1;
        if (row >= NLAT) { const int t = (row - NLAT) & 255; if (c < 448) { if (t > 0) nrow = row - 1; } else { if (t < 255) nrow = row + 1; } }
        else { const int tl = row & (SEQ - 1), col = tl & 63, gr = tl >> 6;
            if (c < 224) { if (col > 0) nrow = row - 1; } else if (c < 448) { if (col < 63) nrow = row + 1; } else if (c < 672) { if (gr > 0) nrow = row - 64; } else { if (gr < 255) nrow = row + 64; } }
        const float z = bf2f(Z[(size_t)row * ZLD + Z_RW + c]); const float zs = nrow >= 0 ? bf2f(Z[(size_t)nrow * ZLD + Z_RW + c]) : 0.f;
        zm[idx] = z + mu[c] * (zs - z);
    }
    __syncthreads();
    for (int idx = tid; idx < 8 * 96; idx += 512) { const int rr = idx / 96, j = idx % 96;
        if (j < 32) tw[rr * 32 + j] = tanhf(zm[rr * 896 + 768 + j]); else sg[rr * 64 + (j - 32)] = sigmoid_(zm[rr * 896 + 832 + (j - 32)]); }
    __syncthreads();
    const int c = tid & 255, th = tid >> 8;
    float aw0[4] = {0, 0, 0, 0}, aw1[4] = {0, 0, 0, 0}, aa0[4] = {0, 0, 0, 0}, aa1[4] = {0, 0, 0, 0}, ag[4] = {0, 0, 0, 0};
    const float* wup0 = p.in[I_RWWUP] + (size_t)(layer * 2 + 0) * 32 * 256 + c; const float* wup1 = wup0 + 32 * 256;
    const float* aup0 = p.in[I_RWAUP] + (size_t)(layer * 2 + 0) * 32 * 256 + c; const float* aup1 = aup0 + 32 * 256;
    const float* gup = p.in[I_RWGUP] + (size_t)layer * 64 * 256 + c;
#pragma unroll 4
    for (int j = 0; j < 32; ++j) { const float w0 = wup0[j * 256], w1 = wup1[j * 256], a0 = aup0[j * 256], a1 = aup1[j * 256];
#pragma unroll
        for (int i = 0; i < 4; ++i) { const int rr = th * 4 + i; const float t = tw[rr * 32 + j], al = zm[rr * 896 + 800 + j];
            aw0[i] += t * w0; aw1[i] += t * w1; aa0[i] += al * a0; aa1[i] += al * a1; } }
#pragma unroll 4
    for (int j = 0; j < 64; ++j) { const float g = gup[j * 256];
#pragma unroll
        for (int i = 0; i < 4; ++i) ag[i] += sg[(th * 4 + i) * 64 + j] * g; }
    bf16_t* op = (bf16_t*)(p.ws + WS_RWOP);
    const float kk_ = p.in[I_RWKK][layer * 256 + c];
    const float w00 = p.in[I_RWW0][(layer * 2 + 0) * 256 + c], w01 = p.in[I_RWW0][(layer * 2 + 1) * 256 + c];
    const float a00 = p.in[I_RWA0][(layer * 2 + 0) * 256 + c], a01 = p.in[I_RWA0][(layer * 2 + 1) * 256 + c];
#pragma unroll
    for (int i = 0; i < 4; ++i) { const int rr = th * 4 + i; const size_t o = (size_t)(row0 + rr) * 256 + c;
        const float r = zm[rr * 896 + c], k = zm[rr * 896 + 256 + c], v = zm[rr * 896 + 512 + c];
        const float kkv = k * kk_; const float ss = wave_sum(kkv * kkv); const float kk = kkv * rsqrtf(ss + 1e-12f);
        const float wr0 = -softplus_(-(w00 + aw0[i])) - 0.5f, wr1 = -softplus_(-(w01 + aw1[i])) - 0.5f;
        const float om0 = -expm1f(-__expf(wr0)), om1 = -expm1f(-__expf(wr1));
        const float as0 = sigmoid_(a00 + aa0[i]), as1 = sigmoid_(a01 + aa1[i]);
        op[RW_R * RWOP_STRIDE + o] = f2bf(r); op[RW_K * RWOP_STRIDE + o] = f2bf(k); op[RW_V * RWOP_STRIDE + o] = f2bf(v); op[RW_KK * RWOP_STRIDE + o] = f2bf(kk);
        op[RW_AS0 * RWOP_STRIDE + o] = f2bf(as0); op[RW_AS1 * RWOP_STRIDE + o] = f2bf(as1); op[RW_OM0 * RWOP_STRIDE + o] = f2bf(om0); op[RW_OM1 * RWOP_STRIDE + o] = f2bf(om1);
        op[RW_G * RWOP_STRIDE + o] = f2bf(ag[i]); }
    __syncthreads();
}
DI int rw_row(int b, int dir, int pp) { if (pp < 256) return NLAT + b * CTXL + (dir ? 255 - pp : pp); const int q = pp - 256; return b * SEQ + (dir ? SEQ - 1 - q : q); }
template <int CTRL> DI float dpp_(float x) { return __int_as_float(__builtin_amdgcn_update_dpp(0, __float_as_int(x), CTRL, 0xf, 0xf, false)); }
DI float row16_allsum(float x) { x += dpp_<0x128>(x); x += dpp_<0x124>(x); x += dpp_<0x122>(x); x += dpp_<0x121>(x); return x; }
DI void rwkv_scan_block(const Params& p, int layer, int blk, unsigned char* lds) {
    const int tid = otid(), chain = blk >> 2, b = chain >> 3, dir = (chain >> 2) & 1, h = chain & 3, vbase = (blk & 3) * 16;
    float* buf = (float*)lds;
    float* ybuf = buf + 2 * 32 * 6 * 64;
    const bf16_t* op = (const bf16_t*)(p.ws + WS_RWOP);
    bf16_t* Z = (bf16_t*)(p.ws + WS_Z);
    const bool loader = tid >= 256; const int lt = tid - 256;
    const int NBATCH = (256 + SEQ) / 32;
    const bf16_t* pAS = op + (dir ? RW_AS1 : RW_AS0) * RWOP_STRIDE; const bf16_t* pOM = op + (dir ? RW_OM1 : RW_OM0) * RWOP_STRIDE;
    float ka[8];
    if (loader) {
#pragma unroll
        for (int i = 0; i < 8; ++i) ka[i] = p.in[I_RWKA][layer * 256 + h * 64 + ((lt + 256 * i) & 63)];
    }
    auto fill = [&](int nb) {
        float* dst = buf + (nb & 1) * (32 * 6 * 64);
        bf16_t lr[8], lk[8], lv[8], lkk[8], las[8], lom[8];
#pragma unroll
        for (int i = 0; i < 8; ++i) { const int q = lt + 256 * i, j = q >> 6, c = q & 63; const size_t o = (size_t)rw_row(b, dir, nb * 32 + j) * 256 + h * 64 + c;
            lr[i] = op[RW_R * RWOP_STRIDE + o]; lk[i] = op[RW_K * RWOP_STRIDE + o]; lv[i] = op[RW_V * RWOP_STRIDE + o]; lkk[i] = op[RW_KK * RWOP_STRIDE + o]; las[i] = pAS[o]; lom[i] = pOM[o]; }
#pragma unroll
        for (int i = 0; i < 8; ++i) { const int q = lt + 256 * i, j = q >> 6, c = q & 63; float* d = dst + j * 384 + c;
            const float r = bf2f(lr[i]), k = bf2f(lk[i]), v = bf2f(lv[i]), kk = bf2f(lkk[i]), as = bf2f(las[i]), om = bf2f(lom[i]);
            d[0] = 1.f - om; d[64] = k * (1.f + (as - 1.f) * ka[i]); d[128] = -kk; d[192] = kk * as; d[256] = r; d[320] = v; }
    };
    auto flush = [&](int nb) {
        const float* src = ybuf + (nb & 1) * 512;
#pragma unroll
        for (int i = 0; i < 2; ++i) { const int idx = lt + 256 * i, j = idx >> 4, vl = idx & 15;
            Z[(size_t)rw_row(b, dir, nb * 32 + j) * ZLD + Z_RW + dir * 256 + h * 64 + vbase + vl] = f2bf(src[idx]); }
    };
    if (loader) fill(0);
    __syncthreads();
    const int wv = tid >> 6, lane = tid & 63, vr = lane >> 4, kl = lane & 15, vloc = wv * 4 + vr;
    float s0 = 0.f, s1 = 0.f, s2 = 0.f, s3 = 0.f;
    for (int nb = 0; nb < NBATCH; ++nb) {
        if (loader) { if (nb + 1 < NBATCH) fill(nb + 1); if (nb >= 1) flush(nb - 1); }
        else {
            const float* src = buf + (nb & 1) * (32 * 6 * 64); float* yd = ybuf + (nb & 1) * 512;
#pragma unroll 2
            for (int j = 0; j < 32; ++j) { const float* sj = src + j * 384;
                const float4 w = *(const float4*)(sj + kl * 4), kd = *(const float4*)(sj + 64 + kl * 4), a = *(const float4*)(sj + 128 + kl * 4), bb = *(const float4*)(sj + 192 + kl * 4), r = *(const float4*)(sj + 256 + kl * 4);
                const float v = sj[320 + vbase + vloc];
                float sa = s0 * a.x + s1 * a.y + s2 * a.z + s3 * a.w; sa = row16_allsum(sa);
                s0 = s0 * w.x + v * kd.x + sa * bb.x; s1 = s1 * w.y + v * kd.y + sa * bb.y; s2 = s2 * w.z + v * kd.z + sa * bb.z; s3 = s3 * w.w + v * kd.w + sa * bb.w;
                float y = s0 * r.x + s1 * r.y + s2 * r.z + s3 * r.w; y = row16_allsum(y);
                if (kl == 0) yd[j * 16 + vloc] = y; }
        }
        __syncthreads();
    }
    if (loader) flush(NBATCH - 1);
    __syncthreads();
}
DI void rwkv_finish_row(const Params& p, int layer, int row, int lane) {
    const bf16_t* Z = (const bf16_t*)(p.ws + WS_Z); const bf16_t* op = (const bf16_t*)(p.ws + WS_RWOP); bf16_t* Y = (bf16_t*)(p.ws + WS_H);
#pragma unroll
    for (int hh = 0; hh < 4; ++hh) { const int c = hh * 64 + lane; const size_t o = (size_t)row * 256 + c;
        const float yv = bf2f(Z[(size_t)row * ZLD + Z_RW + c]) + bf2f(Z[(size_t)row * ZLD + Z_RW + 256 + c]);
        const float mean = wave_sum(yv) * (1.f / 64.f); const float dv = yv - mean; const float var = wave_sum(dv * dv) * (1.f / 64.f);
        const float gn = dv * rsqrtf(var + 64e-5f) * p.in[I_RWLNG][layer * 256 + c] + p.in[I_RWLNB][layer * 256 + c];
        const float r = bf2f(op[RW_R * RWOP_STRIDE + o]), k = bf2f(op[RW_K * RWOP_STRIDE + o]), v = bf2f(op[RW_V * RWOP_STRIDE + o]), g = bf2f(op[RW_G * RWOP_STRIDE + o]);
        const float bonus = wave_sum(r * k * p.in[I_RWRK][layer * 256 + c]) * v;
        Y[(size_t)row * D + 256 + c] = f2bf((gn + bonus) * g); }
}

DI void s5_stage_u(const Params& p, int row0, int g, float* ubuf, int lane) {
    const bf16_t* Z = (const bf16_t*)(p.ws + WS_Z);
    const u32x4* src = (const u32x4*)(Z + (size_t)(row0 + lane) * ZLD + g * 16);
    const u32x4 a = src[0], b = src[1]; float* d = ubuf + lane * 16;
    const unsigned w[8] = {a.x, a.y, a.z, a.w, b.x, b.y, b.z, b.w};
#pragma unroll
    for (int i = 0; i < 8; ++i) { d[2 * i] = __uint_as_float(w[i] << 16); d[2 * i + 1] = __uint_as_float(w[i] & 0xFFFF0000u); }
    WAVE_LDS_SYNC();
}
DI void s5_step(float& hr, float& hi, const float ar, const float ai, const float (&Br)[16], const float (&Bi)[16], const float* u) {
    const float4 u0 = *(const float4*)u, u1 = *(const float4*)(u + 4), u2 = *(const float4*)(u + 8), u3 = *(const float4*)(u + 12);
    const float uu[16] = {u0.x, u0.y, u0.z, u0.w, u1.x, u1.y, u1.z, u1.w, u2.x, u2.y, u2.z, u2.w, u3.x, u3.y, u3.z, u3.w};
    float br = 0.f, bi = 0.f;
#pragma unroll
    for (int q = 0; q < 16; ++q) { br += Br[q] * uu[q]; bi += Bi[q] * uu[q]; }
    const float nr = ar * hr - ai * hi + br, ni = ar * hi + ai * hr + bi; hr = nr; hi = ni;
}
DI void s5_stage1_item(const Params& p, int layer, int item, unsigned char* lds) {
    const int tid = otid(), wave = tid >> 6, lane = tid & 63;
    const int b = item / 1040, rem = item % 1040, ci = rem >> 2, idx = (rem & 3) * 8 + wave, g = idx >> 1, dir = idx & 1;
    float* ubuf = (float*)(lds + wave * 4096);
    const int row0 = chunk_row0(b, ci);
    s5_stage_u(p, row0, g, ubuf, lane);
    const size_t e = ((size_t)(layer * 2 + dir) * 16 + g) * 64 + lane;
    const float* abar = (const float*)(p.ws + WS_S5A); const float* bbar = (const float*)(p.ws + WS_S5B);
    const float ar = abar[e * 2], ai = abar[e * 2 + 1]; float Br[16], Bi[16];
#pragma unroll
    for (int q = 0; q < 8; ++q) { const float4 t = *(const float4*)(bbar + e * 32 + q * 4); Br[2 * q] = t.x; Bi[2 * q] = t.y; Br[2 * q + 1] = t.z; Bi[2 * q + 1] = t.w; }
    float hr = 0.f, hi = 0.f;
    for (int i = 0; i < 64; ++i) { const int t = dir ? 63 - i : i; s5_step(hr, hi, ar, ai, Br, Bi, ubuf + t * 16); }
    float2* E = (float2*)(p.ws + WS_S5E);
    E[((((size_t)b * 2 + dir) * 16 + g) * NCH + ci) * 64 + lane] = make_float2(hr, hi);
    __syncthreads();
}
DI void s5_stage3_item(const Params& p, int layer, int item, unsigned char* lds) {
    const int tid = otid(), wave = tid >> 6, lane = tid & 63, b = item / NCH, ci = item % NCH, row0 = chunk_row0(b, ci);
    float* ubuf = (float*)(lds + wave * 18432);
    float* yb = ubuf + 1024;
    float2* hbuf = (float2*)(yb + 1024);
    float2* cbuf = hbuf + 256;
    const float* abar = (const float*)(p.ws + WS_S5A); const float* bbar = (const float*)(p.ws + WS_S5B); const float2* E = (const float2*)(p.ws + WS_S5E);
    bf16_t* Y = (bf16_t*)(p.ws + WS_H);
    const int pq = lane & 15, tq = lane >> 4;
    for (int gi = 0; gi < 2; ++gi) { const int g = wave * 2 + gi;
        s5_stage_u(p, row0, g, ubuf, lane);
        const float dsk = p.in[I_S5D][layer * 256 + g * 16 + pq];
        for (int dir = 0; dir < 2; ++dir) {
            const size_t e = ((size_t)(layer * 2 + dir) * 16 + g) * 64 + lane;
            const float ar = abar[e * 2], ai = abar[e * 2 + 1]; float Br[16], Bi[16];
#pragma unroll
            for (int q = 0; q < 8; ++q) { const float4 t = *(const float4*)(bbar + e * 32 + q * 4); Br[2 * q] = t.x; Bi[2 * q] = t.y; Br[2 * q + 1] = t.z; Bi[2 * q + 1] = t.w; }
            { const float* cre = p.in[I_S5CRE] + ((size_t)(layer * 2 + dir) * 16 + g) * 16 * 64; const float* cim = p.in[I_S5CIM] + ((size_t)(layer * 2 + dir) * 16 + g) * 16 * 64;
#pragma unroll
              for (int pp = 0; pp < 16; ++pp) cbuf[lane * 16 + pp] = make_float2(cre[pp * 64 + lane], cim[pp * 64 + lane]); }
            float pr = ar, pi = ai;
#pragma unroll
            for (int q = 0; q < 6; ++q) { const float nr = pr * pr - pi * pi, ni = 2.f * pr * pi; pr = nr; pi = ni; }
            float hr = 0.f, hi = 0.f;
            const int pos = chunk_at(dir, ci); const float2* Eb = E + (((size_t)b * 2 + dir) * 16 + g) * NCH * 64 + lane;
#pragma unroll 8
            for (int q = 0; q < pos; ++q) { const float2 ev = Eb[(size_t)chunk_at(dir, q) * 64]; const float nr = pr * hr - pi * hi + ev.x, ni = pr * hi + pi * hr + ev.y; hr = nr; hi = ni; }
            WAVE_LDS_SYNC();
#pragma unroll 1
            for (int sq = 0; sq < 16; ++sq) { const int sb = dir ? 15 - sq : sq;
#pragma unroll 1
                for (int j = 0; j < 4; ++j) { const int tt = dir ? 3 - j : j; s5_step(hr, hi, ar, ai, Br, Bi, ubuf + (sb * 4 + tt) * 16); hbuf[tt * 64 + lane] = make_float2(hr, hi); }
                WAVE_LDS_SYNC();
                float y0 = 0.f;
#pragma unroll 8
                for (int n = 0; n < 64; ++n) { const float2 c = cbuf[n * 16 + pq]; const float2 h0 = hbuf[tq * 64 + n]; y0 += c.x * h0.x - c.y * h0.y; }
                const int t = sb * 4 + tq;
                if (dir == 0) yb[t * 16 + pq] = y0;
                else { const float y = yb[t * 16 + pq] + y0 + dsk * ubuf[t * 16 + pq]; Y[(size_t)(row0 + t) * D + g * 16 + pq] = f2bf(gelu_tanh_(y)); }
                WAVE_LDS_SYNC();
            }
        }
        WAVE_LDS_SYNC();
    }
    __syncthreads();
}
DI bf16x8 ldfrag(const bf16_t* base, int stride, int r0, int k0, int lane) { return *(const bf16x8*)(base + (size_t)(r0 + (lane & 15)) * stride + k0 + (lane >> 4) * 8); }
DI void s5_glu_item(const Params& p, int layer, int item, unsigned char* lds) {
    const int tid = otid(), wave = tid >> 6, lane = tid & 63, r0 = item * 64 + (wave >> 1) * 16, c0 = (wave & 1) * 128;
    bf16_t* Y = (bf16_t*)(p.ws + WS_H); const bf16_t* WT = (const bf16_t*)(p.ws + WS_WTGLU);
    f32x4 acc[8];
#pragma unroll
    for (int t = 0; t < 8; ++t) acc[t] = (f32x4){0.f, 0.f, 0.f, 0.f};
#pragma unroll 1
    for (int k0 = 0; k0 < 256; k0 += 32) { const bf16x8 a = ldfrag(Y, D, r0, k0, lane);
#pragma unroll
        for (int t = 0; t < 8; ++t) { const bf16x8 bfr = ldfrag(WT, 256, c0 + t * 16, k0, lane); acc[t] = __builtin_amdgcn_mfma_f32_16x16x32_bf16(a, bfr, acc[t], 0, 0, 0); } }
    __syncthreads();
    const float* gb = p.in[I_S5GB] + layer * 256;
#pragma unroll
    for (int t = 0; t < 8; ++t) { const int col = c0 + t * 16 + (lane & 15);
#pragma unroll
        for (int j = 0; j < 4; ++j) { bf16_t* py = Y + (size_t)(r0 + (lane >> 4) * 4 + j) * D + col; const float y = bf2f(*py); *py = f2bf(y * sigmoid_(acc[t][j] + gb[col])); } }
    __syncthreads();
}

constexpr int CST = 72;
template <int DK, bool RET> DI void chunk_cum(const Params& p, int layer, int h, int row0, float* cum) {
    const int tid = otid(); const bf16_t* Z = (const bf16_t*)(p.ws + WS_Z);
    for (int idx = tid; idx < 2 * 64 * DK; idx += 512) { const int d = idx / (64 * DK), s = (idx / DK) & 63, k = idx % DK; float la;
        if (RET) la = logsigmoid_(p.in[I_RETDEC][(layer * 2 + d) * 4 + h]);
        else { const float* au = p.in[I_GLAAUP] + (size_t)(layer * 2 + d) * 16 * 128 + h * 32 + k; float x = p.in[I_GLAAB][(layer * 2 + d) * 128 + h * 32 + k];
            const bf16_t* al = Z + (size_t)(row0 + s) * ZLD + Z_GLA + 768;
#pragma unroll
            for (int j = 0; j < 16; ++j) x += bf2f(al[j]) * au[j * 128];
            la = logsigmoid_(x) * (1.f / 16.f); }
        cum[idx] = la; }
    __syncthreads();
    if (tid < 2 * DK) { const int d = tid / DK, k = tid % DK; float* c = cum + d * 64 * DK + k; float acc = 0.f;
        if (d == 0) { for (int s = 0; s < 64; ++s) { acc += c[s * DK]; c[s * DK] = acc; } }
        else { for (int s = 63; s >= 0; --s) { acc += c[s * DK]; c[s * DK] = acc; } } }
    __syncthreads();
}
template <int DK, bool RET> DI void chunk_qk(const Params& p, int h, int row0, int idx, int& s, int& d1, int& d2, float& q1, float& q2, float& k1, float& k2) {
    constexpr int NP = DK / 2; const bf16_t* Z = (const bf16_t*)(p.ws + WS_Z);
    s = idx / NP; const int j = idx % NP;
    if (RET) { d1 = j < 16 ? j : j + 16; d2 = d1 + 16; } else { d1 = j; d2 = j + 16; }
    const int qcol = RET ? Z_RET + h * 64 : Z_GLA + h * 32, kcol = RET ? Z_RET + 256 + h * 64 : Z_GLA + 128 + h * 32;
    const float ksc = RET ? 0.125f : 0.17677669529663687f;
    const bf16_t* zr = Z + (size_t)(row0 + s) * ZLD;
    q1 = bf2f(zr[qcol + d1]); q2 = bf2f(zr[qcol + d2]); k1 = bf2f(zr[kcol + d1]) * ksc; k2 = bf2f(zr[kcol + d2]) * ksc;
    if (RET && row0 < NLAT) { const int tl = (row0 + s) & (SEQ - 1); const float pos = (float)(j < 16 ? (tl >> 6) : (tl & 63));
        const float inv = expf(-(float)(j & 15) * (9.210340371976184f / 16.f)); float sn, cs; sincosf(pos * inv, &sn, &cs);
        float t1 = q1 * cs - q2 * sn, t2 = q1 * sn + q2 * cs; q1 = t1; q2 = t2; t1 = k1 * cs - k2 * sn; t2 = k1 * sn + k2 * cs; k1 = t1; k2 = t2; }
}
template <int DK, bool RET> DI void chunk_stageA(const Params& p, int layer, int item, unsigned char* lds) {
    const int tid = otid(), wave = tid >> 6, lane = tid & 63, b = item / (4 * NCH), h = (item / NCH) & 3, ci = item % NCH, row0 = chunk_row0(b, ci);
    float* cum = (float*)lds; bf16_t* kT0 = (bf16_t*)(lds + 32768); bf16_t* kT1 = kT0 + 64 * CST; bf16_t* vT = (bf16_t*)(lds + 32768 + 4 * 9216);
    const bf16_t* Z = (const bf16_t*)(p.ws + WS_Z);
    chunk_cum<DK, RET>(p, layer, h, row0, cum);
    for (int idx = tid; idx < 64 * (DK / 2); idx += 512) { int s, d1, d2; float q1, q2, k1, k2; chunk_qk<DK, RET>(p, h, row0, idx, s, d1, d2, q1, q2, k1, k2);
        kT0[d1 * CST + s] = f2bf(k1 * __expf(cum[63 * DK + d1] - cum[s * DK + d1])); kT0[d2 * CST + s] = f2bf(k2 * __expf(cum[63 * DK + d2] - cum[s * DK + d2]));
        kT1[d1 * CST + s] = f2bf(k1 * __expf(cum[64 * DK + d1] - cum[64 * DK + s * DK + d1])); kT1[d2 * CST + s] = f2bf(k2 * __expf(cum[64 * DK + d2] - cum[64 * DK + s * DK + d2])); }
    const int vcol = RET ? Z_RET + 512 + h * 64 : Z_GLA + 256 + h * 64;
    for (int idx = tid; idx < 64 * 64; idx += 512) { const int s = idx >> 6, v = idx & 63; vT[v * CST + s] = Z[(size_t)(row0 + s) * ZLD + vcol + v]; }
    float* DEC = (float*)(p.ws + (RET ? WS_DECR : WS_DECG));
    if (tid < 2 * DK) { const int d = tid / DK, k = tid % DK; const int chain = (b * 4 + h) * 2 + d; DEC[((size_t)chain * NCH + ci) * DK + k] = __expf(d == 0 ? cum[63 * DK + k] : cum[64 * DK + k]); }
    __syncthreads();
    bf16_t* CS = (bf16_t*)(p.ws + (RET ? WS_CSR : WS_CSG));
    constexpr int KT = DK / 16;
    for (int tt = wave; tt < 2 * 4 * KT; tt += 8) { const int d = tt / (4 * KT), vt = (tt / KT) & 3, kt = tt % KT; const bf16_t* kT = d ? kT1 : kT0;
        f32x4 acc = {0.f, 0.f, 0.f, 0.f};
#pragma unroll
        for (int s0 = 0; s0 < 64; s0 += 32) acc = __builtin_amdgcn_mfma_f32_16x16x32_bf16(ldfrag(vT, CST, vt * 16, s0, lane), ldfrag(kT, CST, kt * 16, s0, lane), acc, 0, 0, 0);
        const int chain = (b * 4 + h) * 2 + d; bf16_t* dst = CS + ((size_t)chain * NCH + ci) * 64 * DK;
#pragma unroll
        for (int j = 0; j < 4; ++j) dst[(vt * 16 + (lane >> 4) * 4 + j) * DK + kt * 16 + (lane & 15)] = f2bf(acc[j]); }
    __syncthreads();
}
template <int DK, bool RET> DI void chunk_stageB_task(const Params& p, int task) {
    constexpr int GPC = 64 * DK / 8; const int chain = task / GPC, eg = task % GPC, d = chain & 1, k0 = (eg * 8) % DK;
    bf16_t* CS = (bf16_t*)(p.ws + (RET ? WS_CSR : WS_CSG)); const float* DEC = (const float*)(p.ws + (RET ? WS_DECR : WS_DECG));
    float S[8] = {0, 0, 0, 0, 0, 0, 0, 0};
#pragma unroll 4
    for (int pos = 0; pos < NCH; ++pos) { const int ci = chunk_at(d, pos);
        u32x4* ptr = (u32x4*)(CS + ((size_t)chain * NCH + ci) * 64 * DK + eg * 8); const float* dc = DEC + ((size_t)chain * NCH + ci) * DK + k0;
        const u32x4 kv = *ptr; const float4 d0 = *(const float4*)dc, d1 = *(const float4*)(dc + 4);
        u32x4 o; o.x = pk2(S[0], S[1]); o.y = pk2(S[2], S[3]); o.z = pk2(S[4], S[5]); o.w = pk2(S[6], S[7]); *ptr = o;
        const unsigned w[4] = {kv.x, kv.y, kv.z, kv.w}; const float dd[8] = {d0.x, d0.y, d0.z, d0.w, d1.x, d1.y, d1.z, d1.w};
#pragma unroll
        for (int i = 0; i < 4; ++i) { S[2 * i] = dd[2 * i] * S[2 * i] + __uint_as_float(w[i] << 16); S[2 * i + 1] = dd[2 * i + 1] * S[2 * i + 1] + __uint_as_float(w[i] & 0xFFFF0000u); } }
}
template <int DK, bool RET> DI void chunk_stageC(const Params& p, int layer, int item, unsigned char* lds) {
    const int tid = otid(), wave = tid >> 6, lane = tid & 63, b = item / (4 * NCH), h = (item / NCH) & 3, ci = item % NCH, row0 = chunk_row0(b, ci);
    float* cum = (float*)lds; bf16_t* qf = (bf16_t*)(lds + 32768); bf16_t* qb = qf + 64 * CST; bf16_t* kf = qb + 64 * CST; bf16_t* kb = kf + 64 * CST;
    bf16_t* vT = kb + 64 * CST; bf16_t* P = vT + 64 * CST; float* ob = (float*)(lds + 32768 + 6 * 9216);
    const bf16_t* Z = (const bf16_t*)(p.ws + WS_Z);
    chunk_cum<DK, RET>(p, layer, h, row0, cum);
    for (int idx = tid; idx < 64 * (DK / 2); idx += 512) { int s, d1, d2; float q1, q2, k1, k2; chunk_qk<DK, RET>(p, h, row0, idx, s, d1, d2, q1, q2, k1, k2);
        const float cf1 = cum[s * DK + d1], cf2 = cum[s * DK + d2], cb1 = cum[64 * DK + s * DK + d1], cb2 = cum[64 * DK + s * DK + d2];
        qf[s * CST + d1] = f2bf(q1 * __expf(cf1)); qf[s * CST + d2] = f2bf(q2 * __expf(cf2)); qb[s * CST + d1] = f2bf(q1 * __expf(cb1)); qb[s * CST + d2] = f2bf(q2 * __expf(cb2));
        kf[s * CST + d1] = f2bf(k1 * __expf(-cf1)); kf[s * CST + d2] = f2bf(k2 * __expf(-cf2)); kb[s * CST + d1] = f2bf(k1 * __expf(-cb1)); kb[s * CST + d2] = f2bf(k2 * __expf(-cb2)); }
    const int vcol = RET ? Z_RET + 512 + h * 64 : Z_GLA + 256 + h * 64;
    for (int idx = tid; idx < 64 * 64; idx += 512) { const int s = idx >> 6, v = idx & 63; vT[v * CST + s] = Z[(size_t)(row0 + s) * ZLD + vcol + v]; }
    __syncthreads();
#pragma unroll
    for (int i = 0; i < 2; ++i) { const int tt = wave + 8 * i, ti = tt >> 2, si = tt & 3;
        f32x4 aF = {0.f, 0.f, 0.f, 0.f}, aB = {0.f, 0.f, 0.f, 0.f};
        if (si <= ti) {
#pragma unroll
            for (int k0 = 0; k0 < DK; k0 += 32) aF = __builtin_amdgcn_mfma_f32_16x16x32_bf16(ldfrag(qf, CST, ti * 16, k0, lane), ldfrag(kf, CST, si * 16, k0, lane), aF, 0, 0, 0); }
        if (si >= ti) {
#pragma unroll
            for (int k0 = 0; k0 < DK; k0 += 32) aB = __builtin_amdgcn_mfma_f32_16x16x32_bf16(ldfrag(qb, CST, ti * 16, k0, lane), ldfrag(kb, CST, si * 16, k0, lane), aB, 0, 0, 0); }
#pragma unroll
        for (int j = 0; j < 4; ++j) { const int t = ti * 16 + (lane >> 4) * 4 + j, s = si * 16 + (lane & 15);
            const float val = (s < t ? aF[j] : 0.f) + (s > t ? aB[j] : 0.f) + (s == t ? aF[j] + aB[j] : 0.f); P[t * CST + s] = f2bf(val); } }
    __syncthreads();
    const bf16_t* CS = (const bf16_t*)(p.ws + (RET ? WS_CSR : WS_CSG));
    const bf16_t* Sf = CS + ((size_t)((b * 4 + h) * 2 + 0) * NCH + ci) * 64 * DK; const bf16_t* Sb = CS + ((size_t)((b * 4 + h) * 2 + 1) * NCH + ci) * 64 * DK;
#pragma unroll
    for (int i = 0; i < 2; ++i) { const int tt = wave + 8 * i, ti = tt >> 2, vi = tt & 3;
        f32x4 acc = {0.f, 0.f, 0.f, 0.f};
#pragma unroll
        for (int s0 = 0; s0 < 64; s0 += 32) acc = __builtin_amdgcn_mfma_f32_16x16x32_bf16(ldfrag(P, CST, ti * 16, s0, lane), ldfrag(vT, CST, vi * 16, s0, lane), acc, 0, 0, 0);
#pragma unroll
        for (int k0 = 0; k0 < DK; k0 += 32) { acc = __builtin_amdgcn_mfma_f32_16x16x32_bf16(ldfrag(qf, CST, ti * 16, k0, lane), ldfrag(Sf, DK, vi * 16, k0, lane), acc, 0, 0, 0);
            acc = __builtin_amdgcn_mfma_f32_16x16x32_bf16(ldfrag(qb, CST, ti * 16, k0, lane), ldfrag(Sb, DK, vi * 16, k0, lane), acc, 0, 0, 0); }
#pragma unroll
        for (int j = 0; j < 4; ++j) ob[(ti * 16 + (lane >> 4) * 4 + j) * 65 + vi * 16 + (lane & 15)] = acc[j]; }
    __syncthreads();
    { const int t = tid >> 3, v0 = (tid & 7) * 8; float o[8], ss = 0.f;
#pragma unroll
      for (int i = 0; i < 8; ++i) { o[i] = ob[t * 65 + v0 + i]; ss += o[i] * o[i]; }
      ss += __shfl_xor(ss, 1); ss += __shfl_xor(ss, 2); ss += __shfl_xor(ss, 4);
      const float rstd = rsqrtf(ss * (1.f / 64.f) + 1e-6f);
      const int gcol = RET ? Z_RET + 768 + h * 64 : Z_GLA + 512 + h * 64, ycol = RET ? 512 : 768;
      const float* lng = p.in[RET ? I_RETLNG : I_GLALNG] + layer * 256 + h * 64 + v0;
      const bf16_t* gz = Z + (size_t)(row0 + t) * ZLD + gcol + v0; float r[8];
#pragma unroll
      for (int i = 0; i < 8; ++i) r[i] = o[i] * rstd * lng[i] * silu_(bf2f(gz[i]));
      u32x4 w; w.x = pk2(r[0], r[1]); w.y = pk2(r[2], r[3]); w.z = pk2(r[4], r[5]); w.w = pk2(r[6], r[7]);
      *(u32x4*)((bf16_t*)(p.ws + WS_H) + (size_t)(row0 + t) * D + ycol + h * 64 + v0) = w; }
    __syncthreads();
}

DI void phase_m1(const Params& p, int layer, unsigned char* lds) {
    constexpr int N0 = NROW / 8, N1 = 2080, N2 = 2 * 4 * NCH, N3 = 2 * 4 * NCH;
    for (int it = blockIdx.x; it < N0 + N1 + N2 + N3; it += gridDim.x) { int r = it;
        if (r < N0) { rwkv_prep_item(p, layer, r, lds); continue; } r -= N0;
        if (r < N1) { s5_stage1_item(p, layer, r, lds); continue; } r -= N1;
        if (r < N2) { chunk_stageA<64, true>(p, layer, r, lds); continue; } r -= N2;
        chunk_stageA<32, false>(p, layer, r, lds); }
}
DI void phase_m2(const Params& p, int layer, unsigned char* lds) {
    #ifndef DBG_M2
#define DBG_M2 7
#endif
    if (blockIdx.x < 64) { if (DBG_M2 & 1) rwkv_scan_block(p, layer, blockIdx.x, lds); return; }
    const int nb = gridDim.x - 64, bi = blockIdx.x - 64;
    constexpr int NB_B = (16 * 512 + 16 * 256) / 512;
    for (int it = bi; it < NB_B + 2 * NCH; it += nb) {
        if (it < NB_B) { if (DBG_M2 & 2) { const int task = it * 512 + otid(); if (task < 16 * 512) chunk_stageB_task<64, true>(p, task); else chunk_stageB_task<32, false>(p, task - 16 * 512); } continue; }
        if (DBG_M2 & 4) s5_stage3_item(p, layer, it - NB_B, lds); }
}
DI void phase_m3(const Params& p, int layer, unsigned char* lds) {
    constexpr int N0 = NROW / 8, N1 = NROW / 64, N2 = 2 * 4 * NCH, N3 = 2 * 4 * NCH;
    for (int it = blockIdx.x; it < N0 + N1 + N2 + N3; it += gridDim.x) { int r = it;
        if (r < N0) { { const int t_ = otid(); rwkv_finish_row(p, layer, r * 8 + (t_ >> 6), t_ & 63); } continue; } r -= N0;
        if (r < N1) { s5_glu_item(p, layer, r, lds); continue; } r -= N1;
        if (r < N2) { chunk_stageC<64, true>(p, layer, r, lds); continue; } r -= N2;
        chunk_stageC<32, false>(p, layer, r, lds); }
}

__global__ void __launch_bounds__(512) mk_fwd(Params p) {
    extern __shared__ __attribute__((aligned(16))) unsigned char smem[];
    cg::grid_group grid = cg::this_grid();
    for (int ph = p.ph_lo; ph < p.ph_hi; ++ph) {
        if (ph > p.ph_lo) grid.sync();
        if (ph == 0) { if (PH_EN(100)) phase_pre(p, smem); continue; }
        if (ph == NPHASE - 1) { if (PH_EN(101)) phase_final(p); continue; }
        const int layer = (ph - 1) / 9, sub = (ph - 1) % 9;
        const float* modl = (const float*)(p.ws + WS_MOD) + (size_t)layer * 3 * 6144;
        switch (sub) {
        case 0: if (PH_EN(0)) phase_norm(p, layer, 0, smem); break;
        case 1: if (PH_EN(1)) { EpiZ E{(bf16_t*)(p.ws + WS_Z)}; run_gemm(( const bf16_t*)(p.ws + WS_H), (const bf16_t*)(p.ws + WS_WTIN), ZPAD, 1024, E, (PG8_LAS unsigned char*)smem); } break;
        case 2: if (PH_EN(2)) phase_m1(p, layer, smem); break;
        case 3: if (PH_EN(3)) phase_m2(p, layer, smem); break;
        case 4: if (PH_EN(4)) phase_m3(p, layer, smem); break;
        case 5: case 8: if (PH_EN(5)) { const bool o = sub == 5; EpiRes E{p.out, (float*)(p.ws + WS_XCTX), modl + (o ? 2048 : 5120)};
            run_gemm((const bf16_t*)(p.ws + (o ? WS_H : WS_HID)), (const bf16_t*)(p.ws + (o ? WS_WTOUT : WS_WT2)), 1024, o ? 1024 : 4096, E, (PG8_LAS unsigned char*)smem); } break;
        case 6: if (PH_EN(6)) phase_norm(p, layer, 1, smem); break;
        case 7: if (PH_EN(7)) { EpiSq E{(bf16_t*)(p.ws + WS_HID)}; run_gemm((const bf16_t*)(p.ws + WS_H), (const bf16_t*)(p.ws + WS_WT1), DFF, 1024, E, (PG8_LAS unsigned char*)smem); } break;
        }
    }
}

extern "C" void kernel_launch(void* const* d_in, const int* in_sizes, int n_in, void* d_out, int out_size, void* d_ws, size_t ws_size, hipStream_t stream) {
    static int grid = 0;
    if (grid == 0) {
        if (n_in != N_IN || ws_size < WS_END) { fprintf(stderr, "kernel_launch: unexpected n_in %d / ws %zu (need %zu)\n", n_in, ws_size, (size_t)WS_END); grid = -1; return; }
        int dev = 0, cus = 0, per_cu = 0;
        hipGetDevice(&dev); hipDeviceGetAttribute(&cus, hipDeviceAttributeMultiprocessorCount, dev);
        if (hipFuncSetAttribute((const void*)mk_fwd, hipFuncAttributeMaxDynamicSharedMemorySize, LDS_BYTES) != hipSuccess) { fprintf(stderr, "kernel_launch: hipFuncSetAttribute failed\n"); grid = -1; return; }
        hipOccupancyMaxActiveBlocksPerMultiprocessor(&per_cu, (const void*)mk_fwd, 512, LDS_BYTES);
        (void)hipGetLastError();
        if (per_cu < 1) per_cu = 1;
        grid = cus * 1;
        fprintf(stderr, "kernel_launch: cus %d per_cu %d grid %d\n", cus, per_cu, grid);
    }
    if (grid < 0) return;
    Params p{};
    for (int i = 0; i < N_IN; ++i) p.in[i] = (const float*)d_in[i];
    p.out = (float*)d_out; p.ws = (unsigned char*)d_ws;
#if MULTI_LAUNCH
    for (int ph = 0; ph < NPHASE; ++ph) { p.ph_lo = ph; p.ph_hi = ph + 1; hipLaunchKernelGGL(mk_fwd, dim3(grid), dim3(512), LDS_BYTES, stream, p); }
#else
    p.ph_lo = 0; p.ph_hi = NPHASE;
    void* args[] = {&p};
    hipError_t e = hipLaunchCooperativeKernel((const void*)mk_fwd, dim3(grid), dim3(512), args, LDS_BYTES, stream);
    if (e != hipSuccess) fprintf(stderr, "cooperative launch failed: %s (grid %d)\n", hipGetErrorString(e), grid);
#endif
}
```

```cpp
#include <hip/hip_runtime.h>
#include <hip/hip_cooperative_groups.h>
#include <cstdio>
namespace cg = cooperative_groups;
namespace pg8 {
#define PG8_LAS __attribute__((address_space(3)))
typedef unsigned short bf16_t;
typedef short bf16x8 __attribute__((ext_vector_type(8)));
typedef float f32x4 __attribute__((ext_vector_type(4)));
typedef unsigned u32x4 __attribute__((ext_vector_type(4)));
constexpr int BM = 256, BK = 64, HALF = 128, HTB = HALF * BK * 2  , STAGE_BYTES = 8 * HTB, NXCD = 8, WGM = 8;

__host__ __device__ __forceinline__ int lds_byte(int r, int c) { const int st = (r >> 4) * 2 + (c >> 5), rr = r & 15, cc = c & 31, ob = rr * 64 + cc * 2; return st * 1024 + (ob ^ (((ob >> 9) & 1) << 5)); }
__host__ __device__ __forceinline__ void stage_rc(int b, int& R, int& C) { const int st = b / 1024, sb = b % 1024, swz = sb ^ (((sb >> 9) & 1) << 5); R = (st >> 1) * 16 + swz / 64; C = (st & 1) * 32 + (swz % 64) / 2; }
__host__ __device__ __forceinline__ int perm32(int rho) { const int n = rho >> 4, i = rho & 15; return 8 * (i >> 2) + 4 * n + (i & 3); }

struct Unit { int pm, pn; };
struct Gemm { const bf16_t* A; const bf16_t* Bt; int M, N, K; };

struct StaticOrder {
    int nM, nN, nwg, G, c;
    __host__ __device__ void init(int M, int N, int G_, int c_) { nM = M / BM; nN = N / BM; nwg = nM * nN; G = G_; c = c_; }
    __host__ __device__ bool next(int i, Unit& u) const {
        const long L = (long)i * G + c; if (L >= nwg) return false;
        int wgid = (int)L; { const int q = nwg / NXCD, r = nwg % NXCD, xcd = wgid % NXCD, off = wgid / NXCD; wgid = (xcd < r ? xcd * (q + 1) : r * (q + 1) + (xcd - r) * q) + off; }
        const int nig = WGM * nN, gid = wgid / nig, fm = gid * WGM, gsz = (nM - fm) < WGM ? (nM - fm) : WGM;
        u.pm = fm + ((wgid % nig) % gsz); u.pn = (wgid % nig) / gsz; return true;
    }
    __device__ __forceinline__ void a_ready(const Unit&) const {}
    __device__ __forceinline__ void done(const Unit&) const {}
};
__device__ __forceinline__ unsigned cvt_pk_bf16(float lo, float hi) { unsigned r; asm volatile("v_cvt_pk_bf16_f32 %0, %1, %2" : "=v"(r) : "v"(lo), "v"(hi)); return r; }
template <class Epi, class Sched, bool STAMP = false>
__device__ __forceinline__ void gemm_phase(PG8_LAS unsigned char* lds, const Gemm g, const Sched& S, const Epi& E, unsigned long long* stamps) {
    int tid = threadIdx.x; asm volatile("" : "+v"(tid)); const int wid = __builtin_amdgcn_readfirstlane(tid >> 6), lane = tid & 63, wr = wid >> 2, wc = wid & 3, fr = lane & 15, fq = lane >> 4;
    const int K = g.K, nt = K / BK;
    int ts_lo = 0, ts_hi = 0, nts = 0; const unsigned long long rt_entry = STAMP ? (unsigned long long)wall_clock64() : 0ull;
#define PG8_STAMP() do { if (STAMP && wid == 0 && nts < 64) { const unsigned long long _c = (unsigned long long)clock64(); \
        ts_lo = (lane == nts) ? (int)(unsigned)_c : ts_lo; ts_hi = (lane == nts) ? (int)(unsigned)(_c >> 32) : ts_hi; ++nts; } } while (0)
    PG8_STAMP();
    unsigned voffA[2], voffB[2];
#pragma unroll
    for (int i = 0; i < 2; ++i) { int R, C; stage_rc(tid * 16 + i * 8192, R, C); const int Rb = E.perm ? ((R & ~31) + perm32(R & 31)) : R;
        voffA[i] = (unsigned)(R * K + C) * 2u; voffB[i] = (unsigned)(Rb * K + C) * 2u; }
    const size_t kstep = (size_t)(BK * 2);
    const size_t hstep = (size_t)HALF * K * 2;
    const size_t tstep = 2 * hstep;
    const unsigned ldsw = (unsigned)wid * 1024u;
    const int aoff = lds_byte(wr * 64 + fr, fq * 8), boff = lds_byte(wc * 32 + fr, fq * 8);
#define PG8_SA(b, h) (((b) * 2 + (h)) * HTB)
#define PG8_SB(b, h) ((4 + (b) * 2 + (h)) * HTB)
#define PG8_STAGE(bufoff, gbase, voff) do { _Pragma("unroll") for (int _i = 0; _i < 2; ++_i) \
        __builtin_amdgcn_global_load_lds((const unsigned*)((const char*)(gbase) + (voff)[_i]), (PG8_LAS unsigned*)(lds + (bufoff) + ldsw + _i * 8192), 16, 0, 0); } while (0)
#define PG8_LDA(dst, b, h) do { _Pragma("unroll") for (int m = 0; m < 4; ++m) _Pragma("unroll") for (int k = 0; k < 2; ++k) dst[m][k] = *(const PG8_LAS bf16x8*)(lds + PG8_SA(b, h) + aoff + m * 2048 + k * 1024); } while (0)
#define PG8_LDB(dst, b, h) do { _Pragma("unroll") for (int n = 0; n < 2; ++n) _Pragma("unroll") for (int k = 0; k < 2; ++k) dst[n][k] = *(const PG8_LAS bf16x8*)(lds + PG8_SB(b, h) + boff + n * 2048 + k * 1024); } while (0)
#define PG8_MMA(ai, bj, At, Bt) do { __builtin_amdgcn_s_setprio(1); _Pragma("unroll") for (int m = 0; m < 4; ++m) _Pragma("unroll") for (int n = 0; n < 2; ++n) _Pragma("unroll") for (int k = 0; k < 2; ++k) \
        acc[ai][bj][m][n] = __builtin_amdgcn_mfma_f32_16x16x32_bf16(Bt[n][k], At[m][k], acc[ai][bj][m][n], 0, 0, 0); __builtin_amdgcn_s_setprio(0); } while (0)
#define PG8_WAIT_V(n) asm volatile("s_waitcnt vmcnt(" #n ")" ::: "memory")
#define PG8_WAIT_L(n) asm volatile("s_waitcnt lgkmcnt(" #n ")" ::: "memory")
#define PG8_BAR __builtin_amdgcn_s_barrier()
#define PG8_SCHED __builtin_amdgcn_sched_barrier(0)
    Unit cur, nxt; int ui = 0;
    if (!S.next(0, cur)) return;
    f32x4 acc[2][2][4][2];
#pragma unroll
    for (int a = 0; a < 2; ++a)
#pragma unroll
        for (int b = 0; b < 2; ++b)
#pragma unroll
            for (int m = 0; m < 4; ++m)
#pragma unroll
                for (int n = 0; n < 2; ++n) acc[a][b][m][n] = (f32x4){0.f, 0.f, 0.f, 0.f};
    bf16x8 At[4][2], B0[2][2], B1[2][2];
    const char* cA = (const char*)g.A + (size_t)cur.pm * tstep; const char* cB = (const char*)g.Bt + (size_t)cur.pn * tstep;
    S.a_ready(cur);
    PG8_STAGE(PG8_SB(0, 0), cB, voffB); PG8_STAGE(PG8_SA(0, 0), cA, voffA); PG8_STAGE(PG8_SB(0, 1), cB + hstep, voffB); PG8_STAGE(PG8_SA(0, 1), cA + hstep, voffA);
    if (wr == 1) PG8_BAR;
    PG8_WAIT_V(4); PG8_BAR;
    PG8_STAGE(PG8_SB(1, 0), cB + kstep, voffB); PG8_STAGE(PG8_SA(1, 0), cA + kstep, voffA); PG8_STAGE(PG8_SB(1, 1), cB + hstep + kstep, voffB);
    PG8_WAIT_V(6); PG8_BAR;
    PG8_STAMP();
    for (;;) {
        const bool has_next = S.next(ui + 1, nxt);
        const char* nA = has_next ? (const char*)g.A + (size_t)nxt.pm * tstep : cA; const char* nB = has_next ? (const char*)g.Bt + (size_t)nxt.pn * tstep : cB;
        for (int t = 0; t < nt; t += 2) {
            const bool last = (t == nt - 2);
            const char* a1 = cA + (size_t)(t + 1) * kstep;
            const char* a2 = last ? nA : cA + (size_t)(t + 2) * kstep; const char* b2 = last ? nB : cB + (size_t)(t + 2) * kstep;
            const char* a3 = a2 + kstep; const char* b3 = b2 + kstep;
            if (last && has_next) S.a_ready(nxt);
            PG8_LDB(B0, 0, 0); PG8_SCHED; PG8_LDA(At, 0, 0); PG8_STAGE(PG8_SA(1, 1), a1 + hstep, voffA);
            PG8_WAIT_L(8); PG8_BAR; PG8_WAIT_L(0); PG8_MMA(0, 0, At, B0); PG8_BAR; PG8_SCHED;
            PG8_LDB(B1, 0, 1); PG8_STAGE(PG8_SB(0, 0), b2, voffB);
            PG8_BAR; PG8_WAIT_L(0); PG8_MMA(0, 1, At, B1); PG8_BAR;
            PG8_LDA(At, 0, 1); PG8_STAGE(PG8_SA(0, 0), a2, voffA);
            PG8_BAR; PG8_WAIT_L(0); PG8_MMA(1, 0, At, B0); PG8_BAR; PG8_SCHED;
            PG8_STAGE(PG8_SB(0, 1), b2 + hstep, voffB);
            PG8_WAIT_V(6); PG8_BAR; PG8_MMA(1, 1, At, B1); PG8_BAR;
            PG8_LDB(B0, 1, 0); PG8_SCHED; PG8_LDA(At, 1, 0); PG8_STAGE(PG8_SA(0, 1), a2 + hstep, voffA);
            PG8_WAIT_L(8); PG8_BAR; PG8_WAIT_L(0); PG8_MMA(0, 0, At, B0); PG8_BAR; PG8_SCHED;
            PG8_LDB(B1, 1, 1); PG8_STAGE(PG8_SB(1, 0), b3, voffB);
            PG8_BAR; PG8_WAIT_L(0); PG8_MMA(0, 1, At, B1); PG8_BAR;
            PG8_LDA(At, 1, 1); PG8_STAGE(PG8_SA(1, 0), a3, voffA);
            PG8_BAR; PG8_WAIT_L(0); PG8_MMA(1, 0, At, B0); PG8_BAR; PG8_SCHED;
            PG8_STAGE(PG8_SB(1, 1), b3 + hstep, voffB);
            PG8_WAIT_V(6); PG8_BAR; PG8_MMA(1, 1, At, B1); PG8_BAR;
        }
        PG8_STAMP();
        if constexpr (!Epi::AFTER_DRAIN) { E(acc, cur, wr, wc, fr, fq); S.done(cur); }
        PG8_STAMP();
        if (!has_next) break;
#pragma unroll
        for (int a = 0; a < 2; ++a)
#pragma unroll
            for (int b = 0; b < 2; ++b)
#pragma unroll
                for (int m = 0; m < 4; ++m)
#pragma unroll
                    for (int n = 0; n < 2; ++n) acc[a][b][m][n] = (f32x4){0.f, 0.f, 0.f, 0.f};
        cur = nxt; cA = nA; cB = nB; ++ui;
    }
    PG8_WAIT_V(0);
    if (wr == 0) PG8_BAR;
    PG8_BAR;
    if constexpr (Epi::AFTER_DRAIN) { E.fused(acc, cur, wr, wc, fr, fq, lds, wid, lane); S.done(cur); }
    PG8_STAMP();
    if (STAMP && wid == 0) { stamps[lane] = lane < nts ? (((unsigned long long)(unsigned)ts_hi << 32) | (unsigned)ts_lo) : 0ull;
        if (lane == 62) stamps[62] = rt_entry; if (lane == 63) stamps[63] = (unsigned long long)wall_clock64(); }
#undef PG8_STAMP
#undef PG8_SA
#undef PG8_SB
#undef PG8_STAGE
#undef PG8_LDA
#undef PG8_LDB
#undef PG8_MMA
#undef PG8_WAIT_V
#undef PG8_WAIT_L
#undef PG8_BAR
#undef PG8_SCHED
}
}
#define XB_TMO      128
#define XB_XCNT(j)  (256  + 64 * (j))
#define XB_XSUB(j)  (1280 + 64 * (j))
#define XB_XGEN(j)  (2304 + 64 * (j))
#define XB_TOP      3328
#define XB_TOPGEN   3392
#define XCD_BAR_WORDS 3456
#define XB_SPIN_CAP (1u << 18)
#define LAS __attribute__((address_space(3)))

__device__ __forceinline__ unsigned xb_ld(unsigned* p)              { return __hip_atomic_load(p, __ATOMIC_RELAXED, __HIP_MEMORY_SCOPE_AGENT); }
__device__ __forceinline__ unsigned xb_add(unsigned* p, unsigned v) { return __hip_atomic_fetch_add(p, v, __ATOMIC_RELAXED, __HIP_MEMORY_SCOPE_AGENT); }
__device__ __forceinline__ unsigned xb_xcc_id() { return (unsigned)__builtin_amdgcn_s_getreg((3 << 11) | 20) & 0xFu; }
#define XB_SPIN(cond, bar) do { unsigned _sp = 0; while (cond) { __builtin_amdgcn_s_sleep(1); \
    if ((++_sp & 255u) == 0u) { if (xb_ld(&(bar)[XB_TMO])) break; if (_sp > XB_SPIN_CAP) { atomicAdd(&(bar)[XB_TMO], 1u); break; } } } } while (0)

struct XcdBarrier {
    unsigned* bar; unsigned x;
    volatile LAS unsigned* st;
};

__device__ __forceinline__ XcdBarrier xcd_barrier_post(unsigned* bar, volatile LAS unsigned* st) {
    XcdBarrier b; b.bar = bar; b.x = xb_xcc_id(); b.st = st;
    if (threadIdx.x == 0) (void)xb_add(&bar[XB_XCNT(b.x)], 1u);
    return b;
}
__device__ __forceinline__ void xcd_barrier_complete(unsigned* bar, unsigned x, unsigned& nloc, unsigned& nx) {
    const unsigned G = gridDim.x * gridDim.y * gridDim.z;
    unsigned sum, cnt, mine, sp = 0u;
    for (;;) {
        sum = 0u; cnt = 0u; mine = 0u;
#pragma unroll
        for (unsigned j = 0; j < 16; ++j) { const unsigned c = xb_ld(&bar[XB_XCNT(j)]); sum += c; cnt += (c > 0u) ? 1u : 0u; mine = (j == x) ? c : mine; }
        if (sum == G) break;
        __builtin_amdgcn_s_sleep(1);
        if ((++sp & 255u) == 0u) { if (xb_ld(&bar[XB_TMO])) break; if (sp > XB_SPIN_CAP) { atomicAdd(&bar[XB_TMO], 1u); break; } }
    }
    nloc = mine > 0u ? mine : 1u; nx = cnt > 0u ? cnt : 1u;
}

__device__ __forceinline__ void xcd_barrier(const XcdBarrier& b) {
    asm volatile("s_waitcnt vmcnt(0)" ::: "memory");
    __syncthreads();
    if (threadIdx.x == 0) {
        unsigned* bar = b.bar;
        __builtin_amdgcn_s_waitcnt(0);
        unsigned nloc = b.st[0], nx = b.st[1];
        if (nloc == 0u) { xcd_barrier_complete(bar, b.x, nloc, nx); b.st[0] = nloc; b.st[1] = nx; }
        const unsigned old = xb_add(&bar[XB_XSUB(b.x)], 1u);
        const unsigned gen = old / nloc;
        if (old + 1u == (gen + 1u) * nloc) {
            __builtin_amdgcn_fence(__ATOMIC_RELEASE, "agent");
            asm volatile("s_waitcnt vmcnt(0)" ::: "memory");
            const unsigned og = xb_add(&bar[XB_TOP], 1u);
            const unsigned tg = og / nx;
            if (og + 1u == (tg + 1u) * nx) xb_add(&bar[XB_TOPGEN], 1u);
            else XB_SPIN(xb_ld(&bar[XB_TOPGEN]) == tg, bar);
            __builtin_amdgcn_fence(__ATOMIC_ACQUIRE, "agent");
            xb_add(&bar[XB_XGEN(b.x)], 1u);
            asm volatile("s_waitcnt vmcnt(0)" ::: "memory");
        } else {
            XB_SPIN(xb_ld(&bar[XB_XGEN(b.x)]) == gen, bar);
            __builtin_amdgcn_fence(__ATOMIC_ACQUIRE, "agent");
            asm volatile("s_waitcnt vmcnt(0)" ::: "memory");
        }
    }
    __syncthreads();
}

using pg8::bf16_t; using pg8::bf16x8; using pg8::f32x4; using pg8::u32x4;
#define DI __device__ __forceinline__
#ifndef DBG_ONLY
#define DBG_ONLY -1
#endif
#define PH_EN(x) (DBG_ONLY < 0 || DBG_ONLY == (x))
#ifndef PROBE_MASK
#define PROBE_MASK 0
#endif
#ifndef MULTI_LAUNCH
#define MULTI_LAUNCH 0
#endif

enum { I_X = 0, I_C, I_CTX, I_CCTX, I_ADAW, I_ADAB, I_N1G, I_N2G, I_WIN, I_WOUT,
       I_S5LRE, I_S5LIM, I_S5LDT, I_S5BRE, I_S5BIM, I_S5CRE, I_S5CIM, I_S5D, I_S5GW, I_S5GB,
       I_RWMU, I_RWW0, I_RWWUP, I_RWA0, I_RWAUP, I_RWGUP, I_RWKK, I_RWKA, I_RWRK, I_RWLNG, I_RWLNB,
       I_RETDEC, I_RETLNG, I_GLAAUP, I_GLAAB, I_GLALNG, I_W1, I_W2, I_FING, N_IN };

struct Params { const float* in[N_IN]; float* out; unsigned char* ws; int ph_lo, ph_hi; };
extern __shared__ __attribute__((aligned(16))) unsigned char smem[];

constexpr int D = 1024, NB = 2, SEQ = 16384, CTXL = 256;
constexpr int NLAT = NB * SEQ, NROW = NLAT + NB * CTXL;
constexpr int ZLD = 2960, ZPAD = 3072, DFF = 4096, NCH = 260;
constexpr int Z_RW = 256, Z_RET = 1152, Z_GLA = 2176;
constexpr int LDS_MAIN = 144 * 1024;
constexpr int LDS_BYTES = LDS_MAIN + 1024;
#define PIN(i) (((const float* const*)(smem + LDS_MAIN + 64))[(i)])
constexpr int NPHASE = 38;

constexpr size_t al256(size_t x) { return (x + 255) & ~(size_t)255; }
constexpr size_t WS_MOD   = 0;
constexpr size_t WS_S5A   = al256(WS_MOD + (size_t)4 * 3 * 6144 * 4);
constexpr size_t WS_S5B   = al256(WS_S5A + (size_t)4 * 2 * 16 * 64 * 2 * 4);
constexpr size_t WS_XCTX  = al256(WS_S5B + (size_t)4 * 2 * 16 * 64 * 16 * 2 * 4);
constexpr size_t WS_WTIN  = al256(WS_XCTX + (size_t)512 * 1024 * 4);
constexpr size_t WS_WTOUT = al256(WS_WTIN + (size_t)ZPAD * 1024 * 2);
constexpr size_t WS_WT1   = al256(WS_WTOUT + (size_t)1024 * 1024 * 2);
constexpr size_t WS_WT2   = al256(WS_WT1 + (size_t)4096 * 1024 * 2);
constexpr size_t WS_WTGLU = al256(WS_WT2 + (size_t)4096 * 1024 * 2);
constexpr size_t WS_H     = al256(WS_WTGLU + (size_t)256 * 256 * 2);
constexpr size_t WS_S5E   = al256(WS_H + (size_t)NROW * 1024 * 2);
constexpr size_t WS_DECR  = al256(WS_S5E + (size_t)2 * 2 * 16 * NCH * 64 * 2 * 4);
constexpr size_t WS_DECG  = al256(WS_DECR + (size_t)16 * NCH * 64 * 4);
constexpr size_t WS_CSR   = al256(WS_DECG + (size_t)16 * NCH * 32 * 4);
constexpr size_t WS_CSG   = al256(WS_CSR + (size_t)16 * NCH * 64 * 64 * 2);
constexpr size_t WS_Z     = al256(WS_CSG + (size_t)16 * NCH * 64 * 32 * 2);
constexpr size_t WS_RWOP  = al256(WS_Z + (size_t)NROW * ZLD * 2);
constexpr int RWLD = 2560;
constexpr size_t WS_BON   = al256(WS_RWOP + (size_t)NROW * RWLD * 2);
constexpr size_t WS_ROPE  = al256(WS_BON + (size_t)NROW * 4 * 4);
constexpr size_t WS_RWT   = al256(WS_ROPE + (size_t)(256 + 64) * 16 * 8);
constexpr size_t WS_CM    = al256(WS_RWT + (size_t)(4 * 8192 + 16384) * 2);
constexpr size_t WS_ZERO  = al256(WS_CM + (size_t)4 * 2 * 16 * 16 * 128 * 2);
constexpr size_t WS_BAR   = al256(WS_ZERO + (size_t)3 * 6144 * 4);
constexpr size_t WS_END   = al256(WS_BAR + (size_t)XCD_BAR_WORDS * 4);
constexpr size_t WS_HID   = WS_Z;
static_assert((size_t)NROW * DFF * 2 <= WS_END - WS_Z, "hidden alias");

DI int otid() { int t = threadIdx.x; asm volatile("" : "+v"(t)); return t; }
DI float bf2f(bf16_t b) { return __uint_as_float(((unsigned)b) << 16); }
DI bf16_t f2bf(float f) { unsigned u = __float_as_uint(f); u += 0x7FFFu + ((u >> 16) & 1u); return (bf16_t)(u >> 16); }
DI unsigned pk2(float lo, float hi) { return (unsigned)f2bf(lo) | ((unsigned)f2bf(hi) << 16); }
DI float wave_sum(float v) {
#pragma unroll
    for (int o = 1; o < 64; o <<= 1) v += __shfl_xor(v, o);
    return v;
}
DI float sigmoid_(float x) { return 1.f / (1.f + __expf(-x)); }
DI float softplus_(float x) { return fmaxf(x, 0.f) + log1pf(__expf(-fabsf(x))); }
DI float logsigmoid_(float x) { return -softplus_(-x); }
DI float silu_(float x) { return x * sigmoid_(x); }
DI float gelu_tanh_(float x) { const float u = 0.7978845608028654f * (x + 0.044715f * x * x * x); return 0.5f * x * (1.f + tanhf(u)); }
#define WAVE_LDS_SYNC() asm volatile("s_waitcnt lgkmcnt(0)" ::: "memory")

DI float* xrow(const Params& p, int row) { return row < NLAT ? p.out + (size_t)row * D : (float*)(p.ws + WS_XCTX) + (size_t)(row - NLAT) * D; }
DI int chunk_row0(int b, int ci) { return ci < 4 ? NLAT + b * CTXL + ci * 64 : b * SEQ + (ci - 4) * 64; }
DI int chunk_at(int dir, int pos) { return dir == 0 ? pos : (pos < 4 ? 3 - pos : 263 - pos); }
DI int modset(int row) { return row < SEQ ? 0 : (row < NLAT ? 1 : 2); }

struct EpiZ {
    static constexpr bool PERM = true, AFTER_DRAIN = false;
    bf16_t* O;
    DI void operator()(const f32x4 (&acc)[2][2][4][2], const pg8::Unit& u, int wr, int wc, int fr, int fq) const {
        const int row0 = u.pm * 256 + wr * 64 + fr, col0 = u.pn * 256 + wc * 32 + 8 * fq;
#pragma unroll
        for (int ai = 0; ai < 2; ++ai)
#pragma unroll
            for (int m = 0; m < 4; ++m) { bf16_t* rowp = O + (size_t)(row0 + ai * 128 + m * 16) * ZLD + col0;
#pragma unroll
                for (int bj = 0; bj < 2; ++bj) { if (col0 + bj * 128 < ZLD) { const f32x4 v0 = acc[ai][bj][m][0], v1 = acc[ai][bj][m][1];
                    u32x4 w; w.x = pg8::cvt_pk_bf16(v0[0], v0[1]); w.y = pg8::cvt_pk_bf16(v0[2], v0[3]); w.z = pg8::cvt_pk_bf16(v1[0], v1[1]); w.w = pg8::cvt_pk_bf16(v1[2], v1[3]);
                    *(u32x4*)(rowp + bj * 128) = w; } } }
    }
};
struct EpiSq {
    static constexpr bool PERM = true, AFTER_DRAIN = false;
    bf16_t* O;
    DI void operator()(const f32x4 (&acc)[2][2][4][2], const pg8::Unit& u, int wr, int wc, int fr, int fq) const {
        const int row0 = u.pm * 256 + wr * 64 + fr, col0 = u.pn * 256 + wc * 32 + 8 * fq;
#pragma unroll
        for (int ai = 0; ai < 2; ++ai)
#pragma unroll
            for (int m = 0; m < 4; ++m) { bf16_t* rowp = O + (size_t)(row0 + ai * 128 + m * 16) * DFF + col0;
#pragma unroll
                for (int bj = 0; bj < 2; ++bj) { f32x4 v0 = acc[ai][bj][m][0], v1 = acc[ai][bj][m][1];
#pragma unroll
                    for (int j = 0; j < 4; ++j) { const float a = fmaxf(v0[j], 0.f), b = fmaxf(v1[j], 0.f); v0[j] = a * a; v1[j] = b * b; }
                    u32x4 w; w.x = pg8::cvt_pk_bf16(v0[0], v0[1]); w.y = pg8::cvt_pk_bf16(v0[2], v0[3]); w.z = pg8::cvt_pk_bf16(v1[0], v1[1]); w.w = pg8::cvt_pk_bf16(v1[2], v1[3]);
                    *(u32x4*)(rowp + bj * 128) = w; } }
    }
};
struct EpiRes {
    static constexpr bool PERM = false, AFTER_DRAIN = false;
    float* out; float* xctx; const float* gate;
    DI void operator()(const f32x4 (&acc)[2][2][4][2], const pg8::Unit& u, int wr, int wc, int fr, int fq) const {
        const int row0 = u.pm * 256 + wr * 64 + fr, col0 = u.pn * 256 + wc * 32 + 4 * fq;
        const int set = u.pm < 64 ? 0 : (u.pm < 128 ? 1 : 2);
        const float* gp = gate + set * 6144 + col0;
        f32x4 gv[2][2];
#pragma unroll
        for (int bj = 0; bj < 2; ++bj)
#pragma unroll
            for (int n = 0; n < 2; ++n) gv[bj][n] = *(const f32x4*)(gp + bj * 128 + n * 16);
#pragma unroll
        for (int ai = 0; ai < 2; ++ai)
#pragma unroll
            for (int m = 0; m < 4; ++m) { const int row = row0 + ai * 128 + m * 16;
                float* xr = (row < NLAT ? out + (size_t)row * D : xctx + (size_t)(row - NLAT) * D) + col0;
#pragma unroll
                for (int bj = 0; bj < 2; ++bj)
#pragma unroll
                    for (int n = 0; n < 2; ++n) { f32x4* px = (f32x4*)(xr + bj * 128 + n * 16); f32x4 xv = *px; xv = xv + gv[bj][n] * acc[ai][bj][m][n]; *px = xv; } }
    }
};
struct EpiAll {
    static constexpr bool AFTER_DRAIN = false;
    bool perm; int mode; bf16_t* O; float* out; float* xctx; const float* gate;
    DI void operator()(const f32x4 (&acc)[2][2][4][2], const pg8::Unit& u, int wr, int wc, int fr, int fq) const {
        if (mode == 0) { EpiZ e{O}; e(acc, u, wr, wc, fr, fq); }
        else if (mode == 1) { EpiSq e{O}; e(acc, u, wr, wc, fr, fq); }
        else { EpiRes e{out, xctx, gate}; e(acc, u, wr, wc, fr, fq); }
    }
};
template <class Epi> DI void run_gemm(const bf16_t* A, const bf16_t* Bt, int M, int N, int K, const Epi& E, PG8_LAS unsigned char* lds) {
    pg8::Gemm g{A, Bt, M, N, K}; pg8::StaticOrder S; S.init(M, N, (int)gridDim.x, (int)blockIdx.x);
    pg8::gemm_phase<Epi, pg8::StaticOrder, false>(lds, g, S, E, nullptr);
}

DI void mods_items(const Params& p, int layer, unsigned char* lds, int first, int stride) {
    asm volatile("" : "+s"(first), "+s"(stride));
    const int tid = otid();
    float* cond = (float*)lds; float* red = cond + 3 * 1024; float* mod = (float*)(p.ws + WS_MOD);
    if (first >= 96) return;
    for (int i = tid; i < 3072; i += 512) { const int set = i >> 10, k = i & 1023; const float cv = set < 2 ? PIN(I_C)[set * 1024 + k] : PIN(I_CCTX)[k]; cond[i] = silu_(cv); }
    __syncthreads();
    for (int cb = first; cb < 96; cb += stride) {
        const int ks = tid >> 6, c = tid & 63;
        const float* W = PIN(I_ADAW) + (size_t)layer * 1024 * 6144 + cb * 64 + c;
        float a0 = 0.f, a1 = 0.f, a2 = 0.f;
#pragma unroll 8
        for (int k = ks * 128; k < ks * 128 + 128; ++k) { const float w = W[(size_t)k * 6144]; a0 += cond[k] * w; a1 += cond[1024 + k] * w; a2 += cond[2048 + k] * w; }
        red[(ks * 3 + 0) * 64 + c] = a0; red[(ks * 3 + 1) * 64 + c] = a1; red[(ks * 3 + 2) * 64 + c] = a2;
        __syncthreads();
        if (tid < 192) { const int set = tid >> 6, cc = tid & 63; float s = PIN(I_ADAB)[layer * 6144 + cb * 64 + cc];
            for (int q = 0; q < 8; ++q) s += red[(q * 3 + set) * 64 + cc];
            mod[(size_t)(layer * 3 + set) * 6144 + cb * 64 + cc] = s; }
        __syncthreads();
    }
}
DI void phase_pre(const Params& p, unsigned char* lds) {
    const int tid = otid(); const size_t nthr = (size_t)gridDim.x * 512, gtid = (size_t)blockIdx.x * 512 + tid;
    {
      const float4* s2 = (const float4*)PIN(I_CTX); float4* d2 = (float4*)(p.ws + WS_XCTX); for (size_t i = gtid; i < (size_t)512 * D / 4; i += nthr) d2[i] = s2[i]; }
    { float* abar = (float*)(p.ws + WS_S5A); float* bbar = (float*)(p.ws + WS_S5B);
      for (size_t e = gtid; e < (size_t)4 * 2 * 16 * 64; e += nthr) {
        const float lr = fminf(PIN(I_S5LRE)[e], -1e-4f), li = PIN(I_S5LIM)[e], dt = expf(PIN(I_S5LDT)[e >> 6]);
        const float th = li * dt; float sn, cs; sincosf(th, &sn, &cs); const float em = expm1f(lr * dt), sh = sinf(0.5f * th);
        const float ar = (em + 1.f) * cs, ai = (em + 1.f) * sn; const float nr = em * cs - 2.f * sh * sh, ni = ai;
        const float den = 1.f / (lr * lr + li * li); const float qr = (nr * lr + ni * li) * den, qi = (ni * lr - nr * li) * den;
        abar[e * 2] = ar; abar[e * 2 + 1] = ai;
        for (int pp = 0; pp < 16; ++pp) { const float br = PIN(I_S5BRE)[e * 16 + pp], bi = PIN(I_S5BIM)[e * 16 + pp];
            bbar[(e * 16 + pp) * 2] = qr * br - qi * bi; bbar[(e * 16 + pp) * 2 + 1] = qr * bi + qi * br; } }
      bf16_t* cm = (bf16_t*)(p.ws + WS_CM);
      for (size_t e = gtid; e < (size_t)4 * 2 * 16 * 16 * 64; e += nthr) { const size_t gdp = e >> 6; const int n = (int)(e & 63);
        cm[gdp * 128 + 2 * n] = f2bf(PIN(I_S5CRE)[e]); cm[gdp * 128 + 2 * n + 1] = f2bf(-PIN(I_S5CIM)[e]); } }
    { float2* rope = (float2*)(p.ws + WS_ROPE);
      for (size_t e = gtid; e < (size_t)(256 + 64) * 16; e += nthr) { const int f = (int)(e & 15); const float pos = (float)(e < 4096 ? (e >> 4) : ((e - 4096) >> 4));
        const float inv = expf(-(float)f * (9.210340371976184f / 16.f)); float sn, cs; sincosf(pos * inv, &sn, &cs); rope[e] = make_float2(cs, sn); } }
    { float* zz = (float*)(p.ws + WS_ZERO); for (size_t e = gtid; e < (size_t)3 * 6144; e += nthr) zz[e] = 0.f; }
    mods_items(p, 0, lds, blockIdx.x, gridDim.x);
}

DI void transpose_item(const float* W, int K, int N, int Npad, bf16_t* WT, float* scr, int item, int lane) {
    const int nblk = Npad / 32, kb = item / nblk, nb = item % nblk, k0 = 64 * kb, n0 = 32 * nb;
    const int n = n0 + (lane & 31);
#pragma unroll 8
    for (int i = 0; i < 32; ++i) { const int kk = 2 * i + (lane >> 5); scr[kk * 33 + (lane & 31)] = n < N ? W[(size_t)(k0 + kk) * N + n] : 0.f; }
    WAVE_LDS_SYNC();
    const int c = lane & 7;
#pragma unroll
    for (int j = 0; j < 4; ++j) { const int nn = (lane >> 3) + 8 * j; const float* s = scr + (8 * c) * 33 + nn;
        u32x4 o; o.x = pk2(s[0 * 33], s[1 * 33]); o.y = pk2(s[2 * 33], s[3 * 33]); o.z = pk2(s[4 * 33], s[5 * 33]); o.w = pk2(s[6 * 33], s[7 * 33]);
        *(u32x4*)(WT + (size_t)(n0 + nn) * K + k0 + 8 * c) = o; }
    WAVE_LDS_SYNC();
}
DI void phase_norm(const Params& p, int layer, int which, unsigned char* lds) {
    const int nrows = (layer == 3 && which == 1) ? NLAT : NROW;
    const int tid = otid(), wave = tid >> 6, lane = tid & 63, gw = blockIdx.x * 8 + wave, NGW = gridDim.x * 8;
    if (which == 0) {
        float* scr = (float*)(lds + wave * 8704);
        constexpr int I_IN = 16 * 96, I_G = 4 * 8;
        for (int it = gw; it < I_IN + I_G; it += NGW) {
            int r = it;
            if (r < I_IN) { transpose_item(PIN(I_WIN) + (size_t)layer * 1024 * ZLD, 1024, ZLD, ZPAD, (bf16_t*)(p.ws + WS_WTIN), scr, r, lane); continue; } r -= I_IN;
            transpose_item(PIN(I_S5GW) + (size_t)layer * 256 * 256, 256, 256, 256, (bf16_t*)(p.ws + WS_WTGLU), scr, r, lane);
        }
    }
    if (which == 0) {
        bf16_t* rwt = (bf16_t*)(p.ws + WS_RWT); const int gt = blockIdx.x * 512 + tid, ngt = gridDim.x * 512;
        for (int i = gt; i < 4 * 8192 + 16384; i += ngt) {
            if (i < 4 * 8192) { const int m = i >> 13, r = i & 8191, c = r >> 5, k = r & 31;
                const float* src = (m < 2 ? PIN(I_RWWUP) : PIN(I_RWAUP)) + (size_t)(layer * 2 + (m & 1)) * 32 * 256; rwt[i] = f2bf(src[k * 256 + c]); }
            else { const int r = i - 4 * 8192, c = r >> 6, k = r & 63; rwt[i] = f2bf(PIN(I_RWGUP)[(size_t)layer * 64 * 256 + k * 256 + c]); } }
    }
    const float* gam = PIN(which == 0 ? I_N1G : I_N2G) + layer * 1024;
    const float* modl = (const float*)(p.ws + WS_MOD) + (size_t)layer * 3 * 6144 + (which == 0 ? 0 : 3072);
    bf16_t* H = (bf16_t*)(p.ws + WS_H);
    for (int row = gw * 2; row < nrows; row += NGW * 2) {
        const bool first = layer == 0 && which == 0 && row < NLAT;
        const float* xr = first ? PIN(I_X) + (size_t)row * D : xrow(p, row); const float* sh = modl + modset(row) * 6144; const float* sc = sh + 1024;
        float4 v[2][4];
#pragma unroll
        for (int r2 = 0; r2 < 2; ++r2)
#pragma unroll
            for (int j = 0; j < 4; ++j) v[r2][j] = *(const float4*)(xr + (size_t)r2 * D + 4 * lane + 256 * j);
#pragma unroll
        for (int r2 = 0; r2 < 2; ++r2) {
            float ss = 0.f;
#pragma unroll
            for (int j = 0; j < 4; ++j) ss += v[r2][j].x * v[r2][j].x + v[r2][j].y * v[r2][j].y + v[r2][j].z * v[r2][j].z + v[r2][j].w * v[r2][j].w;
            if (first) {
#pragma unroll
                for (int j = 0; j < 4; ++j) *(float4*)(p.out + (size_t)(row + r2) * D + 4 * lane + 256 * j) = v[r2][j]; }
            const float rstd = rsqrtf(wave_sum(ss) * (1.f / 1024.f) + 1e-6f);
#pragma unroll
            for (int j = 0; j < 4; ++j) { const int c = 4 * lane + 256 * j; const float4 g = *(const float4*)(gam + c), s1 = *(const float4*)(sc + c), s0 = *(const float4*)(sh + c);
                const float o0 = v[r2][j].x * rstd * g.x * (1.f + s1.x) + s0.x, o1 = v[r2][j].y * rstd * g.y * (1.f + s1.y) + s0.y, o2 = v[r2][j].z * rstd * g.z * (1.f + s1.z) + s0.z, o3 = v[r2][j].w * rstd * g.w * (1.f + s1.w) + s0.w;
                uint2 w; w.x = pk2(o0, o1); w.y = pk2(o2, o3); *(uint2*)(H + (size_t)(row + r2) * D + c) = w; } }
    }
}
DI void phase_final(const Params& p) {
    const int tid = otid(), wave = tid >> 6, lane = tid & 63, gw = blockIdx.x * 8 + wave, NGW = gridDim.x * 8;
    const float* gam = PIN(I_FING);
    for (int row = gw; row < NLAT; row += NGW) {
        float* xr = p.out + (size_t)row * D; float4 v[4]; float ss = 0.f;
#pragma unroll
        for (int j = 0; j < 4; ++j) { v[j] = *(const float4*)(xr + 4 * lane + 256 * j); ss += v[j].x * v[j].x + v[j].y * v[j].y + v[j].z * v[j].z + v[j].w * v[j].w; }
        const float rstd = rsqrtf(wave_sum(ss) * (1.f / 1024.f) + 1e-6f);
#pragma unroll
        for (int j = 0; j < 4; ++j) { const int c = 4 * lane + 256 * j; const float4 g = *(const float4*)(gam + c);
            float4 o; o.x = v[j].x * rstd * g.x; o.y = v[j].y * rstd * g.y; o.z = v[j].z * rstd * g.z; o.w = v[j].w * rstd * g.w; *(float4*)(xr + c) = o; }
    }
}

DI bf16x8 ldfrag(const bf16_t* base, int stride, int r0, int k0, int lane);
DI void rwkv_prep_item(const Params& p, int layer, int item, unsigned char* lds) {
    const int tid = otid(), wave = tid >> 6, lane = tid & 63, row0 = item * 16;
    float* zm = (float*)lds;
    bf16_t* TW = (bf16_t*)(lds + 57344);
    bf16_t* AL = TW + 16 * 40;
    bf16_t* SG = AL + 16 * 40;
    float* SS = (float*)(lds + 57344 + 8192);
    const bf16_t* Z = (const bf16_t*)(p.ws + WS_Z);
    const float* mu = PIN(I_RWMU) + layer * 896;
    for (int idx = tid; idx < 16 * 112; idx += 512) {
        const int rr = idx / 112, c0 = (idx % 112) * 8, row = row0 + rr; int nrow = -1;
        if (row >= NLAT) { const int t = (row - NLAT) & 255; if (c0 < 448) { if (t > 0) nrow = row - 1; } else { if (t < 255) nrow = row + 1; } }
        else { const int tl = row & (SEQ - 1), col = tl & 63, gr = tl >> 6;
            if (c0 < 224) { if (col > 0) nrow = row - 1; } else if (c0 < 448) { if (col < 63) nrow = row + 1; } else if (c0 < 672) { if (gr > 0) nrow = row - 64; } else { if (gr < 255) nrow = row + 64; } }
        const u32x4 zq = *(const u32x4*)(Z + (size_t)row * ZLD + Z_RW + c0);
        u32x4 nq = {0u, 0u, 0u, 0u}; if (nrow >= 0) nq = *(const u32x4*)(Z + (size_t)nrow * ZLD + Z_RW + c0);
        const float4 m0 = *(const float4*)(mu + c0), m1 = *(const float4*)(mu + c0 + 4);
        const unsigned zw[4] = {zq.x, zq.y, zq.z, zq.w}, nw[4] = {nq.x, nq.y, nq.z, nq.w}; const float mm[8] = {m0.x, m0.y, m0.z, m0.w, m1.x, m1.y, m1.z, m1.w}; float o[8];
#pragma unroll
        for (int i = 0; i < 4; ++i) { const float z0 = __uint_as_float(zw[i] << 16), z1 = __uint_as_float(zw[i] & 0xFFFF0000u), s0 = __uint_as_float(nw[i] << 16), s1 = __uint_as_float(nw[i] & 0xFFFF0000u);
            o[2 * i] = z0 + mm[2 * i] * (s0 - z0); o[2 * i + 1] = z1 + mm[2 * i + 1] * (s1 - z1); }
        *(float4*)(zm + rr * 896 + c0) = make_float4(o[0], o[1], o[2], o[3]); *(float4*)(zm + rr * 896 + c0 + 4) = make_float4(o[4], o[5], o[6], o[7]);
    }
    __syncthreads();
    float* bon = (float*)(p.ws + WS_BON);
    for (int idx = tid; idx < 16 * 128; idx += 512) { const int rr = idx >> 7, j = idx & 127;
        if (j < 32) TW[rr * 40 + j] = f2bf(tanhf(zm[rr * 896 + 768 + j])); else if (j < 64) AL[rr * 40 + (j - 32)] = f2bf(zm[rr * 896 + 800 + (j - 32)]); else SG[rr * 72 + (j - 64)] = f2bf(sigmoid_(zm[rr * 896 + 832 + (j - 64)])); }
    { const int rr = tid >> 5, hd = (tid >> 3) & 3, part = tid & 7; float ss = 0.f, bs = 0.f;
#pragma unroll
      for (int i = 0; i < 8; ++i) { const int c = hd * 64 + part * 8 + i; const float r = zm[rr * 896 + c], k = zm[rr * 896 + 256 + c]; const float kkv = k * PIN(I_RWKK)[layer * 256 + c]; ss += kkv * kkv; bs += r * k * PIN(I_RWRK)[layer * 256 + c]; }
      ss += __shfl_xor(ss, 1); ss += __shfl_xor(ss, 2); ss += __shfl_xor(ss, 4); bs += __shfl_xor(bs, 1); bs += __shfl_xor(bs, 2); bs += __shfl_xor(bs, 4);
      if (part == 0) { SS[rr * 4 + hd] = ss; bon[(size_t)(row0 + rr) * 4 + hd] = bs; } }
    __syncthreads();
    const bf16_t* rwt = (const bf16_t*)(p.ws + WS_RWT); bf16_t* op = (bf16_t*)(p.ws + WS_RWOP);
    const int quad = lane >> 4, col = lane & 15;
    const bf16x8 twf = ldfrag(TW, 40, 0, 0, lane), alf = ldfrag(AL, 40, 0, 0, lane), sg0 = ldfrag(SG, 72, 0, 0, lane), sg1 = ldfrag(SG, 72, 0, 32, lane);
#pragma unroll 1
    for (int ci = 0; ci < 2; ++ci) { const int c = (wave * 2 + ci) * 16 + col;
        const f32x4 z4 = {0.f, 0.f, 0.f, 0.f};
        const f32x4 w0 = __builtin_amdgcn_mfma_f32_16x16x32_bf16(twf, *(const bf16x8*)(rwt + 0 * 8192 + c * 32 + quad * 8), z4, 0, 0, 0);
        const f32x4 w1 = __builtin_amdgcn_mfma_f32_16x16x32_bf16(twf, *(const bf16x8*)(rwt + 1 * 8192 + c * 32 + quad * 8), z4, 0, 0, 0);
        const f32x4 a0 = __builtin_amdgcn_mfma_f32_16x16x32_bf16(alf, *(const bf16x8*)(rwt + 2 * 8192 + c * 32 + quad * 8), z4, 0, 0, 0);
        const f32x4 a1 = __builtin_amdgcn_mfma_f32_16x16x32_bf16(alf, *(const bf16x8*)(rwt + 3 * 8192 + c * 32 + quad * 8), z4, 0, 0, 0);
        f32x4 gg = __builtin_amdgcn_mfma_f32_16x16x32_bf16(sg0, *(const bf16x8*)(rwt + 4 * 8192 + c * 64 + quad * 8), z4, 0, 0, 0);
        gg = __builtin_amdgcn_mfma_f32_16x16x32_bf16(sg1, *(const bf16x8*)(rwt + 4 * 8192 + c * 64 + 32 + quad * 8), gg, 0, 0, 0);
        const float kk_ = PIN(I_RWKK)[layer * 256 + c], ka_ = PIN(I_RWKA)[layer * 256 + c];
        const float w00 = PIN(I_RWW0)[(layer * 2 + 0) * 256 + c], w01 = PIN(I_RWW0)[(layer * 2 + 1) * 256 + c];
        const float a00 = PIN(I_RWA0)[(layer * 2 + 0) * 256 + c], a01 = PIN(I_RWA0)[(layer * 2 + 1) * 256 + c];
#pragma unroll
        for (int j = 0; j < 4; ++j) { const int rr = quad * 4 + j; bf16_t* o = op + (size_t)(row0 + rr) * RWLD + c;
            const float r = zm[rr * 896 + c], k = zm[rr * 896 + 256 + c], v = zm[rr * 896 + 512 + c];
            const float kk = k * kk_ * rsqrtf(SS[rr * 4 + (c >> 6)] + 1e-12f);
            const float x0 = -(w00 + w0[j]), x1 = -(w01 + w1[j]);
            const float wr0 = -(fmaxf(x0, 0.f) + __logf(1.f + __expf(-fabsf(x0)))) - 0.5f, wr1 = -(fmaxf(x1, 0.f) + __logf(1.f + __expf(-fabsf(x1)))) - 0.5f;
            const float e0 = __expf(wr0), e1 = __expf(wr1);
            const float om0 = -expm1f(-e0), om1 = -expm1f(-e1);
            const float as0 = sigmoid_(a00 + a0[j]), as1 = sigmoid_(a01 + a1[j]);
            o[0] = f2bf(r); o[256] = f2bf(v); o[512] = f2bf(-kk);
            o[768] = f2bf(om0); o[1024] = f2bf(k * (1.f + (as0 - 1.f) * ka_)); o[1280] = f2bf(kk * as0);
            o[1536] = f2bf(om1); o[1792] = f2bf(k * (1.f + (as1 - 1.f) * ka_)); o[2048] = f2bf(kk * as1);
            o[2304] = f2bf(gg[j]); }
    }
    __syncthreads();
}
DI int rw_row(int b, int dir, int pp) { if (pp < 256) return NLAT + b * CTXL + (dir ? 255 - pp : pp); const int q = pp - 256; return b * SEQ + (dir ? SEQ - 1 - q : q); }
template <int CTRL> DI float dpp_(float x) { return __int_as_float(__builtin_amdgcn_update_dpp(0, __float_as_int(x), CTRL, 0xf, 0xf, false)); }
DI float row16_allsum(float x) { x += dpp_<0x128>(x); x += dpp_<0x124>(x); x += dpp_<0x122>(x); x += dpp_<0x121>(x); return x; }
typedef float f32x2_ __attribute__((ext_vector_type(2)));
#ifndef SCAN_SYNC1
#define SCAN_SYNC1 170
#define SCAN_SYNC2 340
#endif
DI void rwkv_scan_block(const Params& p, int layer, int blk, unsigned char* lds, const XcdBarrier& xb) {
    const int tid = otid(), chain = blk >> 2, b = chain >> 3, dir = (chain >> 2) & 1, h = chain & 3, vbase = (blk & 3) * 16;
    constexpr int SST = 352;
    float* buf = (float*)lds;
    float* ybuf = buf + 2 * 32 * SST;
    const bf16_t* op = (const bf16_t*)(p.ws + WS_RWOP);
    bf16_t* Z = (bf16_t*)(p.ws + WS_Z);
    const bool loader = tid >= 256; const int lt = tid - 256;
    const int NBATCH = (256 + SEQ) / 32;
    const int lj = lt >> 3, part = lt & 7;
    u32x4 raw[6];
#pragma unroll
    for (int i = 0; i < 6; ++i) raw[i] = (u32x4){0u, 0u, 0u, 0u};
    auto gload = [&](int nb) {
        const int pp = nb * 32 + lj; const int pn = pp + 1 < 256 + SEQ ? pp + 1 : pp;
        const bf16_t* base = op + (size_t)rw_row(b, dir, pp) * RWLD + h * 64 + part * 8;
        raw[0] = *(const u32x4*)(base + 768 + dir * 768); raw[1] = *(const u32x4*)(base + 1024 + dir * 768);
        raw[2] = *(const u32x4*)(op + (size_t)rw_row(b, dir, pn) * RWLD + h * 64 + part * 8 + 512);
        raw[3] = *(const u32x4*)(base + 1280 + dir * 768); raw[4] = *(const u32x4*)(base); raw[5] = *(const u32x4*)(base + 256);
    };
    auto lwrite = [&](int nb) {
        float* dst = buf + (nb & 1) * (32 * SST) + lj * SST + part * 8;
        float4 lo[6], hi[6];
#pragma unroll
        for (int i = 0; i < 6; ++i) { const u32x4 q = raw[i];
            lo[i].x = __uint_as_float(q.x << 16); lo[i].y = __uint_as_float(q.x & 0xFFFF0000u); lo[i].z = __uint_as_float(q.y << 16); lo[i].w = __uint_as_float(q.y & 0xFFFF0000u);
            hi[i].x = __uint_as_float(q.z << 16); hi[i].y = __uint_as_float(q.z & 0xFFFF0000u); hi[i].z = __uint_as_float(q.w << 16); hi[i].w = __uint_as_float(q.w & 0xFFFF0000u);
            if (i < 5) { *(float4*)(dst + i * 64) = lo[i]; *(float4*)(dst + i * 64 + 4) = hi[i]; }
            }
        float be = lo[3].x * lo[2].x + lo[3].y * lo[2].y + lo[3].z * lo[2].z + lo[3].w * lo[2].w + hi[3].x * hi[2].x + hi[3].y * hi[2].y + hi[3].z * hi[2].z + hi[3].w * hi[2].w;
        be += __shfl_xor(be, 1); be += __shfl_xor(be, 2); be += __shfl_xor(be, 4);
        if ((part >> 1) == (vbase >> 4)) { float* dv = buf + (nb & 1) * (32 * SST) + lj * SST + 320 + (part & 1) * 16;
            *(float4*)dv = make_float4(lo[5].x, be, lo[5].y, be); *(float4*)(dv + 4) = make_float4(lo[5].z, be, lo[5].w, be); *(float4*)(dv + 8) = make_float4(hi[5].x, be, hi[5].y, be); *(float4*)(dv + 12) = make_float4(hi[5].z, be, hi[5].w, be); }
    };
    auto flush = [&](int nb) {
        const float* src = ybuf + (nb & 1) * 4096;
#pragma unroll
        for (int i = 0; i < 2; ++i) { const int idx = lt + 256 * i, j = idx >> 4, vl = idx & 15; const float4 q = *(const float4*)(src + idx * 8), q2 = *(const float4*)(src + idx * 8 + 4);
            Z[(size_t)rw_row(b, dir, nb * 32 + j) * ZLD + Z_RW + dir * 256 + h * 64 + vbase + vl] = f2bf(((q.x + q.y) + (q.z + q.w)) + ((q2.x + q2.y) + (q2.z + q2.w))); }
    };
    if (loader) { gload(0); lwrite(0); gload(1); }
    __syncthreads();
    const int wv = tid >> 6, lane = tid & 63, vr = lane >> 4, kl = lane & 15, vloc = wv * 4 + vr;
    f32x2_ s01 = {0.f, 0.f}, s23 = {0.f, 0.f}; float sa = 0.f;
    for (int nb = 0; nb < NBATCH; ++nb) {
        if (loader) { if (nb + 1 < NBATCH) lwrite(nb + 1); if (nb + 2 < NBATCH) gload(nb + 2); if (nb >= 1) flush(nb - 1); }
        else {
            const float* base_ = buf + (nb & 1) * (32 * SST);
            unsigned yoff_ = (unsigned)((2 * 32 * SST + (nb & 1) * 4096 + vloc * 8 + (kl & 7)) * 4); asm volatile("" : "+v"(yoff_));
            float* yd = (float*)(lds + yoff_);
#define SC_LD(J, W, KD, AN, B, R, V, BE) { const float* sj_ = base_ + (J) * SST; W = *(const float4*)(sj_ + kl * 4); KD = *(const float4*)(sj_ + 64 + kl * 4); AN = *(const float4*)(sj_ + 128 + kl * 4); \
                B = *(const float4*)(sj_ + 192 + kl * 4); R = *(const float4*)(sj_ + 256 + kl * 4); { const float2 vb_ = *(const float2*)(sj_ + 320 + 2 * vloc); V = vb_.x; BE = vb_.y; } }
            float4 w, kd, an, bb, r, w1, kd1, an1, bb1, r1; float v, v1, be, be1;
            SC_LD(0, w, kd, an, bb, r, v, be); SC_LD(1, w1, kd1, an1, bb1, r1, v1, be1);
#pragma unroll 16
            for (int j = 0; j < 32; ++j) {
                const int jn = j < 30 ? j + 2 : 31;
                float4 wn, kdn, ann, bn, rn; float vn, ben; SC_LD(jn, wn, kdn, ann, bn, rn, vn, ben);
                const f32x2_ vv = {v, v};
                const f32x2_ u01 = s01 - s01 * (f32x2_){w.x, w.y} + vv * (f32x2_){kd.x, kd.y}, u23 = s23 - s23 * (f32x2_){w.z, w.w} + vv * (f32x2_){kd.z, kd.w};
                f32x2_ t = u01 * (f32x2_){an.x, an.y}; t = u23 * (f32x2_){an.z, an.w} + t;
                const float rsum = row16_allsum(t.x + t.y);
                const f32x2_ sav = {sa, sa};
                s01 = (f32x2_){bb.x, bb.y} * sav + u01; s23 = (f32x2_){bb.z, bb.w} * sav + u23;
                f32x2_ yv = s01 * (f32x2_){r.x, r.y}; yv = s23 * (f32x2_){r.z, r.w} + yv;
                float y = yv.x + yv.y; y += dpp_<0x128>(y);
                yd[j * 128] = y;
                sa = rsum + sa * be;
                w = w1; kd = kd1; an = an1; bb = bb1; r = r1; v = v1; be = be1; w1 = wn; kd1 = kdn; an1 = ann; bb1 = bn; r1 = rn; v1 = vn; be1 = ben; }
#undef SC_LD
        }
        __syncthreads();
    }
    if (loader) flush(NBATCH - 1);
    __syncthreads();
}
DI void rwkv_finish_row(const Params& p, int layer, int row, int lane) {
    const bf16_t* Z = (const bf16_t*)(p.ws + WS_Z) + (size_t)row * ZLD; const bf16_t* op = (const bf16_t*)(p.ws + WS_RWOP) + (size_t)row * RWLD; bf16_t* Y = (bf16_t*)(p.ws + WS_H);
    const int c = lane * 4, hh = lane >> 4; const float bonus = ((const float*)(p.ws + WS_BON))[(size_t)row * 4 + hh];
    const uint2 yf = *(const uint2*)(Z + Z_RW + c), yb = *(const uint2*)(Z + Z_RW + 256 + c), vq = *(const uint2*)(op + 256 + c), gq = *(const uint2*)(op + 2304 + c);
    float y[4] = {__uint_as_float(yf.x << 16) + __uint_as_float(yb.x << 16), __uint_as_float(yf.x & 0xFFFF0000u) + __uint_as_float(yb.x & 0xFFFF0000u),
                  __uint_as_float(yf.y << 16) + __uint_as_float(yb.y << 16), __uint_as_float(yf.y & 0xFFFF0000u) + __uint_as_float(yb.y & 0xFFFF0000u)};
    const float v[4] = {__uint_as_float(vq.x << 16), __uint_as_float(vq.x & 0xFFFF0000u), __uint_as_float(vq.y << 16), __uint_as_float(vq.y & 0xFFFF0000u)};
    const float g[4] = {__uint_as_float(gq.x << 16), __uint_as_float(gq.x & 0xFFFF0000u), __uint_as_float(gq.y << 16), __uint_as_float(gq.y & 0xFFFF0000u)};
    const float mean = row16_allsum((y[0] + y[1]) + (y[2] + y[3])) * (1.f / 64.f);
    float d[4], q = 0.f;
#pragma unroll
    for (int i = 0; i < 4; ++i) { d[i] = y[i] - mean; q += d[i] * d[i]; }
    const float rstd = rsqrtf(row16_allsum(q) * (1.f / 64.f) + 64e-5f);
    const float4 lg = *(const float4*)(PIN(I_RWLNG) + layer * 256 + c), lb = *(const float4*)(PIN(I_RWLNB) + layer * 256 + c);
    const float lgv[4] = {lg.x, lg.y, lg.z, lg.w}, lbv[4] = {lb.x, lb.y, lb.z, lb.w}; float o[4];
#pragma unroll
    for (int i = 0; i < 4; ++i) o[i] = (d[i] * rstd * lgv[i] + lbv[i] + bonus * v[i]) * g[i];
    uint2 w; w.x = pk2(o[0], o[1]); w.y = pk2(o[2], o[3]); *(uint2*)(Y + (size_t)row * D + 256 + c) = w;
}

DI void s5_stage_u(const Params& p, int row0, int g, float* ubuf, int lane) {
    const bf16_t* Z = (const bf16_t*)(p.ws + WS_Z);
    const u32x4* src = (const u32x4*)(Z + (size_t)(row0 + lane) * ZLD + g * 16);
    const u32x4 a = src[0], b = src[1]; float* d = ubuf + lane * 16;
    const unsigned w[8] = {a.x, a.y, a.z, a.w, b.x, b.y, b.z, b.w};
#pragma unroll
    for (int i = 0; i < 8; ++i) { d[2 * i] = __uint_as_float(w[i] << 16); d[2 * i + 1] = __uint_as_float(w[i] & 0xFFFF0000u); }
    WAVE_LDS_SYNC();
}
DI void s5_step(float& hr, float& hi, const float ar, const float ai, const float (&Br)[16], const float (&Bi)[16], const float* u) {
    const float4 u0 = *(const float4*)u, u1 = *(const float4*)(u + 4), u2 = *(const float4*)(u + 8), u3 = *(const float4*)(u + 12);
    const float uu[16] = {u0.x, u0.y, u0.z, u0.w, u1.x, u1.y, u1.z, u1.w, u2.x, u2.y, u2.z, u2.w, u3.x, u3.y, u3.z, u3.w};
    float br = 0.f, bi = 0.f;
#pragma unroll
    for (int q = 0; q < 16; ++q) { br += Br[q] * uu[q]; bi += Bi[q] * uu[q]; }
    const float nr = ar * hr - ai * hi + br, ni = ar * hi + ai * hr + bi; hr = nr; hi = ni;
}
DI void s5_stage1_item(const Params& p, int layer, int item, unsigned char* lds) {
    const int tid = otid(), wave = tid >> 6, lane = tid & 63;
    const int b = item / 1040, rem = item % 1040, ci = rem >> 2, idx = (rem & 3) * 8 + wave, g = idx >> 1, dir = idx & 1;
    float* ubuf = (float*)(lds + wave * 4096);
    const int row0 = chunk_row0(b, ci);
    s5_stage_u(p, row0, g, ubuf, lane);
    const size_t e = ((size_t)(layer * 2 + dir) * 16 + g) * 64 + lane;
    const float* abar = (const float*)(p.ws + WS_S5A); const float* bbar = (const float*)(p.ws + WS_S5B);
    const float ar = abar[e * 2], ai = abar[e * 2 + 1]; float Br[16], Bi[16];
#pragma unroll
    for (int q = 0; q < 8; ++q) { const float4 t = *(const float4*)(bbar + e * 32 + q * 4); Br[2 * q] = t.x; Bi[2 * q] = t.y; Br[2 * q + 1] = t.z; Bi[2 * q + 1] = t.w; }
    float hr = 0.f, hi = 0.f;
    for (int i = 0; i < 64; ++i) { const int t = dir ? 63 - i : i; s5_step(hr, hi, ar, ai, Br, Bi, ubuf + t * 16); }
    float2* E = (float2*)(p.ws + WS_S5E);
    E[((((size_t)b * 2 + dir) * 16 + g) * NCH + ci) * 64 + lane] = make_float2(hr, hi);
    __syncthreads();
}
DI bf16x8 ldfrag_l(const bf16_t* base, int stride, int r0, int k0, int lane) { return *(const bf16x8*)(base + (size_t)(r0 + (lane & 15)) * stride + k0 + (lane >> 4) * 8); }
DI void s5_stage3_item(const Params& p, int layer, int item, unsigned char* lds) {
    const int tid = otid(), wave = tid >> 6, lane = tid & 63, b = item / NCH, ci = item % NCH, row0 = chunk_row0(b, ci);
    float* ubuf = (float*)(lds + wave * 18432);
    float* yb = ubuf + 1024;
    bf16_t* Hl = (bf16_t*)(yb + 1024);
    constexpr int HST = 136;
    const float* abar = (const float*)(p.ws + WS_S5A); const float* bbar = (const float*)(p.ws + WS_S5B); const float2* E = (const float2*)(p.ws + WS_S5E);
    bf16_t* Y = (bf16_t*)(p.ws + WS_H);
    const int quad = lane >> 4, col = lane & 15;
#pragma unroll 1
    for (int gi = 0; gi < 2; ++gi) { const int g = wave * 2 + gi;
        s5_stage_u(p, row0, g, ubuf, lane);
        const float dsk = PIN(I_S5D)[layer * 256 + g * 16 + col];
#pragma unroll 1
        for (int dir = 0; dir < 2; ++dir) {
            const size_t gd = (size_t)(layer * 2 + dir) * 16 + g, e = gd * 64 + lane;
            const float ar = abar[e * 2], ai = abar[e * 2 + 1]; float Br[16], Bi[16];
#pragma unroll
            for (int q = 0; q < 8; ++q) { const float4 t = *(const float4*)(bbar + e * 32 + q * 4); Br[2 * q] = t.x; Bi[2 * q] = t.y; Br[2 * q + 1] = t.z; Bi[2 * q + 1] = t.w; }
            bf16x8 Cf[4]; { const bf16_t* cm = (const bf16_t*)(p.ws + WS_CM) + (gd * 16 + col) * 128;
#pragma unroll
              for (int kk = 0; kk < 4; ++kk) Cf[kk] = *(const bf16x8*)(cm + kk * 32 + quad * 8); }
            const float2 h0_ = E[((((size_t)b * 2 + dir) * 16 + g) * NCH + ci) * 64 + lane]; float hr = h0_.x, hi = h0_.y;
#pragma unroll 1
            for (int q = 0; q < 4; ++q) { const int ti = dir ? 3 - q : q;
#pragma unroll 1
                for (int i = 0; i < 16; ++i) { const int tt = dir ? 15 - i : i; s5_step(hr, hi, ar, ai, Br, Bi, ubuf + (ti * 16 + tt) * 16); *(unsigned*)(Hl + tt * HST + 2 * lane) = pk2(hr, hi); }
                WAVE_LDS_SYNC();
                f32x4 acc = {0.f, 0.f, 0.f, 0.f};
#pragma unroll
                for (int kk = 0; kk < 4; ++kk) acc = __builtin_amdgcn_mfma_f32_16x16x32_bf16(ldfrag_l(Hl, HST, 0, kk * 32, lane), Cf[kk], acc, 0, 0, 0);
#pragma unroll
                for (int j = 0; j < 4; ++j) { const int t = ti * 16 + quad * 4 + j;
                    if (dir == 0) yb[t * 16 + col] = acc[j];
                    else { const float y = yb[t * 16 + col] + acc[j] + dsk * ubuf[t * 16 + col]; Y[(size_t)(row0 + t) * D + g * 16 + col] = f2bf(gelu_tanh_(y)); } }
                WAVE_LDS_SYNC(); }
        }
        WAVE_LDS_SYNC();
    }
    __syncthreads();
}
DI bf16x8 ldfrag(const bf16_t* base, int stride, int r0, int k0, int lane) { return *(const bf16x8*)(base + (size_t)(r0 + (lane & 15)) * stride + k0 + (lane >> 4) * 8); }
DI void s5_glu_item(const Params& p, int layer, int item, unsigned char* lds) {
    const int tid = otid(), wave = tid >> 6, lane = tid & 63, r0 = item * 64 + (wave >> 1) * 16, c0 = (wave & 1) * 128;
    bf16_t* Y = (bf16_t*)(p.ws + WS_H); const bf16_t* WT = (const bf16_t*)(p.ws + WS_WTGLU);
    f32x4 acc[8];
#pragma unroll
    for (int t = 0; t < 8; ++t) acc[t] = (f32x4){0.f, 0.f, 0.f, 0.f};
#pragma unroll 1
    for (int k0 = 0; k0 < 256; k0 += 32) { const bf16x8 a = ldfrag(Y, D, r0, k0, lane);
#pragma unroll
        for (int t = 0; t < 8; ++t) { const bf16x8 bfr = ldfrag(WT, 256, c0 + t * 16, k0, lane); acc[t] = __builtin_amdgcn_mfma_f32_16x16x32_bf16(a, bfr, acc[t], 0, 0, 0); } }
    __syncthreads();
    const float* gb = PIN(I_S5GB) + layer * 256;
#pragma unroll
    for (int t = 0; t < 8; ++t) { const int col = c0 + t * 16 + (lane & 15);
#pragma unroll
        for (int j = 0; j < 4; ++j) { bf16_t* py = Y + (size_t)(r0 + (lane >> 4) * 4 + j) * D + col; const float y = bf2f(*py); *py = f2bf(y * sigmoid_(acc[t][j] + gb[col])); } }
    __syncthreads();
}

constexpr int CST = 72;
DI float flogsig_(float x) { return -(fmaxf(-x, 0.f) + __logf(1.f + __expf(-fabsf(x)))); }
DI void gla_cum(const Params& p, int layer, int h, int row0, float* cum, int tid) {
    const int wave = __builtin_amdgcn_readfirstlane(tid >> 6), lane = tid & 63; const bf16_t* Z = (const bf16_t*)(p.ws + WS_Z);
    const u32x4* ap = (const u32x4*)(Z + (size_t)(row0 + lane) * ZLD + Z_GLA + 768); const u32x4 q0 = ap[0], q1 = ap[1];
    const unsigned w[8] = {q0.x, q0.y, q0.z, q0.w, q1.x, q1.y, q1.z, q1.w}; float al[16];
#pragma unroll
    for (int i = 0; i < 8; ++i) { al[2 * i] = __uint_as_float(w[i] << 16); al[2 * i + 1] = __uint_as_float(w[i] & 0xFFFF0000u); }
#pragma unroll
    for (int i = 0; i < 8; ++i) { const int c = wave * 8 + i, d = c >> 5, k = c & 31;
        const float* au = PIN(I_GLAAUP) + (size_t)(layer * 2 + d) * 16 * 128 + h * 32 + k; float x = PIN(I_GLAAB)[(layer * 2 + d) * 128 + h * 32 + k];
#pragma unroll
        for (int j = 0; j < 16; ++j) x += al[j] * au[j * 128];
        x = flogsig_(x) * (1.f / 16.f);
        if (d == 0) {
#pragma unroll
            for (int o = 1; o < 64; o <<= 1) { const float t = __shfl_up(x, o); if (lane >= o) x += t; } }
        else {
#pragma unroll
            for (int o = 1; o < 64; o <<= 1) { const float t = __shfl_down(x, o); if (lane + o < 64) x += t; } }
        cum[(d * 64 + lane) * 32 + k] = x; }
}
struct QK4 { float q1[4], q2[4], k1[4], k2[4]; int d1, d2; };
template <int DK, bool RET> DI void chunk_loadqk(const Params& p, int h, int row0, int ci, int s, int pp, QK4& o) {
    const bf16_t* Z = (const bf16_t*)(p.ws + WS_Z); const bf16_t* zr = Z + (size_t)(row0 + s) * ZLD;
    if (RET) { const int hi = pp >> 2, off = (pp & 3) * 4; o.d1 = hi * 32 + off; o.d2 = o.d1 + 16;
        const int qcol = Z_RET + h * 64, kcol = Z_RET + 256 + h * 64;
        const uint2 a = *(const uint2*)(zr + qcol + o.d1), b = *(const uint2*)(zr + qcol + o.d2), c = *(const uint2*)(zr + kcol + o.d1), d = *(const uint2*)(zr + kcol + o.d2);
        o.q1[0] = __uint_as_float(a.x << 16); o.q1[1] = __uint_as_float(a.x & 0xFFFF0000u); o.q1[2] = __uint_as_float(a.y << 16); o.q1[3] = __uint_as_float(a.y & 0xFFFF0000u);
        o.q2[0] = __uint_as_float(b.x << 16); o.q2[1] = __uint_as_float(b.x & 0xFFFF0000u); o.q2[2] = __uint_as_float(b.y << 16); o.q2[3] = __uint_as_float(b.y & 0xFFFF0000u);
        o.k1[0] = __uint_as_float(c.x << 16); o.k1[1] = __uint_as_float(c.x & 0xFFFF0000u); o.k1[2] = __uint_as_float(c.y << 16); o.k1[3] = __uint_as_float(c.y & 0xFFFF0000u);
        o.k2[0] = __uint_as_float(d.x << 16); o.k2[1] = __uint_as_float(d.x & 0xFFFF0000u); o.k2[2] = __uint_as_float(d.y << 16); o.k2[3] = __uint_as_float(d.y & 0xFFFF0000u);
#pragma unroll
        for (int e = 0; e < 4; ++e) { o.k1[e] *= 0.125f; o.k2[e] *= 0.125f; }
        if (ci >= 4) { const float2* rope = (const float2*)(p.ws + WS_ROPE) + (hi == 0 ? (ci - 4) * 16 : 4096 + s * 16) + off;
#pragma unroll
            for (int e = 0; e < 4; ++e) { const float2 cs = rope[e]; float t1 = o.q1[e] * cs.x - o.q2[e] * cs.y, t2 = o.q1[e] * cs.y + o.q2[e] * cs.x; o.q1[e] = t1; o.q2[e] = t2;
                t1 = o.k1[e] * cs.x - o.k2[e] * cs.y; t2 = o.k1[e] * cs.y + o.k2[e] * cs.x; o.k1[e] = t1; o.k2[e] = t2; } }
    } else { o.d1 = pp * 4; o.d2 = 0; const int qcol = Z_GLA + h * 32, kcol = Z_GLA + 128 + h * 32;
        const uint2 a = *(const uint2*)(zr + qcol + o.d1), c = *(const uint2*)(zr + kcol + o.d1);
        o.q1[0] = __uint_as_float(a.x << 16); o.q1[1] = __uint_as_float(a.x & 0xFFFF0000u); o.q1[2] = __uint_as_float(a.y << 16); o.q1[3] = __uint_as_float(a.y & 0xFFFF0000u);
        o.k1[0] = __uint_as_float(c.x << 16) * 0.17677669529663687f; o.k1[1] = __uint_as_float(c.x & 0xFFFF0000u) * 0.17677669529663687f; o.k1[2] = __uint_as_float(c.y << 16) * 0.17677669529663687f; o.k1[3] = __uint_as_float(c.y & 0xFFFF0000u) * 0.17677669529663687f;
#pragma unroll
        for (int e = 0; e < 4; ++e) { o.q2[e] = 0.f; o.k2[e] = 0.f; } }
}
template <bool RET> DI void chunk_loadv(const Params& p, int h, int row0, int s, int pp, bf16_t* vT) {
    const bf16_t* Z = (const bf16_t*)(p.ws + WS_Z); const int vcol = RET ? Z_RET + 512 + h * 64 : Z_GLA + 256 + h * 64;
    const u32x4 q = *(const u32x4*)(Z + (size_t)(row0 + s) * ZLD + vcol + pp * 8); const unsigned w[4] = {q.x, q.y, q.z, q.w};
#pragma unroll
    for (int i = 0; i < 4; ++i) { vT[(pp * 8 + 2 * i) * CST + s] = (bf16_t)(w[i] & 0xFFFFu); vT[(pp * 8 + 2 * i + 1) * CST + s] = (bf16_t)(w[i] >> 16); }
}
template <int DK, bool RET> DI void chunk_stageA(const Params& p, int layer, int item, unsigned char* lds) {
    const int tid = otid(), wave = tid >> 6, lane = tid & 63, b = item / (4 * NCH), h = (item / NCH) & 3, ci = item % NCH, row0 = chunk_row0(b, ci);
    float* cum = (float*)lds; bf16_t* kT0 = (bf16_t*)(lds + 32768); bf16_t* kT1 = kT0 + 64 * CST; bf16_t* vT = (bf16_t*)(lds + 32768 + 4 * 9216);
    const int s = tid >> 3, pp = tid & 7;
    float la0 = 0.f, la1 = 0.f;
    if (RET) { la0 = flogsig_(PIN(I_RETDEC)[(layer * 2 + 0) * 4 + h]); la1 = flogsig_(PIN(I_RETDEC)[(layer * 2 + 1) * 4 + h]); }
    else { gla_cum(p, layer, h, row0, cum, tid); __syncthreads(); }
    QK4 x; chunk_loadqk<DK, RET>(p, h, row0, ci, s, pp, x);
    chunk_loadv<RET>(p, h, row0, s, pp, vT);
    if (RET) { const float e0 = __expf(la0 * (float)(63 - s)), e1 = __expf(la1 * (float)s);
#pragma unroll
        for (int e = 0; e < 4; ++e) { kT0[(x.d1 + e) * CST + s] = f2bf(x.k1[e] * e0); kT0[(x.d2 + e) * CST + s] = f2bf(x.k2[e] * e0); kT1[(x.d1 + e) * CST + s] = f2bf(x.k1[e] * e1); kT1[(x.d2 + e) * CST + s] = f2bf(x.k2[e] * e1); }
    } else {
#pragma unroll
        for (int e = 0; e < 4; ++e) { const int d = x.d1 + e;
            kT0[d * CST + s] = f2bf(x.k1[e] * __expf(cum[63 * 32 + d] - cum[s * 32 + d])); kT1[d * CST + s] = f2bf(x.k1[e] * __expf(cum[64 * 32 + d] - cum[(64 + s) * 32 + d])); } }
    float* DEC = (float*)(p.ws + (RET ? WS_DECR : WS_DECG));
    if (tid < 2 * DK) { const int d = tid / DK, k = tid % DK; const int chain = (b * 4 + h) * 2 + d;
        DEC[((size_t)chain * NCH + ci) * DK + k] = RET ? __expf(64.f * (d ? la1 : la0)) : __expf(d == 0 ? cum[63 * 32 + k] : cum[64 * 32 + k]); }
    __syncthreads();
    bf16_t* CS = (bf16_t*)(p.ws + (RET ? WS_CSR : WS_CSG));
    constexpr int KT = DK / 16;
    for (int tt = wave; tt < 2 * 4 * KT; tt += 8) { const int d = tt / (4 * KT), vt = (tt / KT) & 3, kt = tt % KT; const bf16_t* kT = d ? kT1 : kT0;
        f32x4 acc = {0.f, 0.f, 0.f, 0.f};
#pragma unroll
        for (int s0 = 0; s0 < 64; s0 += 32) acc = __builtin_amdgcn_mfma_f32_16x16x32_bf16(ldfrag(vT, CST, vt * 16, s0, lane), ldfrag(kT, CST, kt * 16, s0, lane), acc, 0, 0, 0);
        const int chain = (b * 4 + h) * 2 + d; bf16_t* dst = CS + ((size_t)chain * NCH + ci) * 64 * DK;
#pragma unroll
        for (int j = 0; j < 4; ++j) dst[(vt * 16 + (lane >> 4) * 4 + j) * DK + kt * 16 + (lane & 15)] = f2bf(acc[j]); }
    __syncthreads();
}
template <int DK, bool RET> DI void chunk_stageB_task(const Params& p, int task) {
    constexpr int GPC = 64 * DK / 8; const int chain = task / GPC, eg = task % GPC, d = chain & 1, k0 = (eg * 8) % DK;
    bf16_t* CS = (bf16_t*)(p.ws + (RET ? WS_CSR : WS_CSG)); const float* DEC = (const float*)(p.ws + (RET ? WS_DECR : WS_DECG));
    float S[8] = {0, 0, 0, 0, 0, 0, 0, 0};
    for (int pos0 = 0; pos0 < NCH; pos0 += 4) {
        u32x4 kv[4]; float4 d0[4], d1[4];
#pragma unroll
        for (int i = 0; i < 4; ++i) { const int ci = chunk_at(d, pos0 + i); kv[i] = *(const u32x4*)(CS + ((size_t)chain * NCH + ci) * 64 * DK + eg * 8);
            const float* dc = DEC + ((size_t)chain * NCH + ci) * DK + k0; d0[i] = *(const float4*)dc; d1[i] = *(const float4*)(dc + 4); }
#pragma unroll
        for (int i = 0; i < 4; ++i) { const int ci = chunk_at(d, pos0 + i); u32x4* ptr = (u32x4*)(CS + ((size_t)chain * NCH + ci) * 64 * DK + eg * 8);
            u32x4 o; o.x = pk2(S[0], S[1]); o.y = pk2(S[2], S[3]); o.z = pk2(S[4], S[5]); o.w = pk2(S[6], S[7]); *ptr = o;
            const unsigned w[4] = {kv[i].x, kv[i].y, kv[i].z, kv[i].w}; const float dd[8] = {d0[i].x, d0[i].y, d0[i].z, d0[i].w, d1[i].x, d1[i].y, d1[i].z, d1[i].w};
#pragma unroll
            for (int j = 0; j < 4; ++j) { S[2 * j] = dd[2 * j] * S[2 * j] + __uint_as_float(w[j] << 16); S[2 * j + 1] = dd[2 * j + 1] * S[2 * j + 1] + __uint_as_float(w[j] & 0xFFFF0000u); } } }
}
template <int DK, bool RET> DI void chunk_stageC(const Params& p, int layer, int item, unsigned char* lds) {
    const int tid = otid(), wave = tid >> 6, lane = tid & 63, b = item / (4 * NCH), h = (item / NCH) & 3, ci = item % NCH, row0 = chunk_row0(b, ci);
    float* cum = (float*)lds; bf16_t* qf = (bf16_t*)(lds + 32768); bf16_t* qb = qf + 64 * CST; bf16_t* kf = qb + 64 * CST; bf16_t* kb = kf + 64 * CST;
    bf16_t* vT = kb + 64 * CST; bf16_t* P = vT + 64 * CST; float* ob = (float*)(lds + 32768 + 6 * 9216);
    const bf16_t* Z = (const bf16_t*)(p.ws + WS_Z);
    { const int s = tid >> 3, pp = tid & 7;
      if (!RET) { gla_cum(p, layer, h, row0, cum, tid); __syncthreads(); }
      QK4 x; chunk_loadqk<DK, RET>(p, h, row0, ci, s, pp, x);
      chunk_loadv<RET>(p, h, row0, s, pp, vT);
      if (RET) { const float la0 = flogsig_(PIN(I_RETDEC)[(layer * 2 + 0) * 4 + h]), la1 = flogsig_(PIN(I_RETDEC)[(layer * 2 + 1) * 4 + h]);
          const float cf = la0 * (float)(s + 1), cb = la1 * (float)(64 - s); const float ef = __expf(cf), eb = __expf(cb), nf = __expf(-cf), nb_ = __expf(-cb);
          uint2 w;
          w.x = pk2(x.q1[0] * ef, x.q1[1] * ef); w.y = pk2(x.q1[2] * ef, x.q1[3] * ef); *(uint2*)(qf + s * CST + x.d1) = w; w.x = pk2(x.q2[0] * ef, x.q2[1] * ef); w.y = pk2(x.q2[2] * ef, x.q2[3] * ef); *(uint2*)(qf + s * CST + x.d2) = w;
          w.x = pk2(x.q1[0] * eb, x.q1[1] * eb); w.y = pk2(x.q1[2] * eb, x.q1[3] * eb); *(uint2*)(qb + s * CST + x.d1) = w; w.x = pk2(x.q2[0] * eb, x.q2[1] * eb); w.y = pk2(x.q2[2] * eb, x.q2[3] * eb); *(uint2*)(qb + s * CST + x.d2) = w;
          w.x = pk2(x.k1[0] * nf, x.k1[1] * nf); w.y = pk2(x.k1[2] * nf, x.k1[3] * nf); *(uint2*)(kf + s * CST + x.d1) = w; w.x = pk2(x.k2[0] * nf, x.k2[1] * nf); w.y = pk2(x.k2[2] * nf, x.k2[3] * nf); *(uint2*)(kf + s * CST + x.d2) = w;
          w.x = pk2(x.k1[0] * nb_, x.k1[1] * nb_); w.y = pk2(x.k1[2] * nb_, x.k1[3] * nb_); *(uint2*)(kb + s * CST + x.d1) = w; w.x = pk2(x.k2[0] * nb_, x.k2[1] * nb_); w.y = pk2(x.k2[2] * nb_, x.k2[3] * nb_); *(uint2*)(kb + s * CST + x.d2) = w;
      } else { float a[4], bq[4], c[4], d[4];
#pragma unroll
          for (int e = 0; e < 4; ++e) { const float cf = cum[s * 32 + x.d1 + e], cb = cum[(64 + s) * 32 + x.d1 + e]; a[e] = x.q1[e] * __expf(cf); bq[e] = x.q1[e] * __expf(cb); c[e] = x.k1[e] * __expf(-cf); d[e] = x.k1[e] * __expf(-cb); }
          uint2 w; w.x = pk2(a[0], a[1]); w.y = pk2(a[2], a[3]); *(uint2*)(qf + s * CST + x.d1) = w; w.x = pk2(bq[0], bq[1]); w.y = pk2(bq[2], bq[3]); *(uint2*)(qb + s * CST + x.d1) = w;
          w.x = pk2(c[0], c[1]); w.y = pk2(c[2], c[3]); *(uint2*)(kf + s * CST + x.d1) = w; w.x = pk2(d[0], d[1]); w.y = pk2(d[2], d[3]); *(uint2*)(kb + s * CST + x.d1) = w; } }
    __syncthreads();
#pragma unroll
    for (int i = 0; i < 2; ++i) { const int tt = wave + 8 * i, ti = tt >> 2, si = tt & 3;
        f32x4 aF = {0.f, 0.f, 0.f, 0.f}, aB = {0.f, 0.f, 0.f, 0.f};
        if (si <= ti) {
#pragma unroll
            for (int k0 = 0; k0 < DK; k0 += 32) aF = __builtin_amdgcn_mfma_f32_16x16x32_bf16(ldfrag(qf, CST, ti * 16, k0, lane), ldfrag(kf, CST, si * 16, k0, lane), aF, 0, 0, 0); }
        if (si >= ti) {
#pragma unroll
            for (int k0 = 0; k0 < DK; k0 += 32) aB = __builtin_amdgcn_mfma_f32_16x16x32_bf16(ldfrag(qb, CST, ti * 16, k0, lane), ldfrag(kb, CST, si * 16, k0, lane), aB, 0, 0, 0); }
#pragma unroll
        for (int j = 0; j < 4; ++j) { const int t = ti * 16 + (lane >> 4) * 4 + j, s = si * 16 + (lane & 15);
            const float val = (s < t ? aF[j] : 0.f) + (s > t ? aB[j] : 0.f) + (s == t ? aF[j] + aB[j] : 0.f); P[t * CST + s] = f2bf(val); } }
    __syncthreads();
    const bf16_t* CS = (const bf16_t*)(p.ws + (RET ? WS_CSR : WS_CSG));
    const bf16_t* Sf = CS + ((size_t)((b * 4 + h) * 2 + 0) * NCH + ci) * 64 * DK; const bf16_t* Sb = CS + ((size_t)((b * 4 + h) * 2 + 1) * NCH + ci) * 64 * DK;
#pragma unroll
    for (int i = 0; i < 2; ++i) { const int tt = wave + 8 * i, ti = tt >> 2, vi = tt & 3;
        f32x4 acc = {0.f, 0.f, 0.f, 0.f};
#pragma unroll
        for (int s0 = 0; s0 < 64; s0 += 32) acc = __builtin_amdgcn_mfma_f32_16x16x32_bf16(ldfrag(P, CST, ti * 16, s0, lane), ldfrag(vT, CST, vi * 16, s0, lane), acc, 0, 0, 0);
#pragma unroll
        for (int k0 = 0; k0 < DK; k0 += 32) { acc = __builtin_amdgcn_mfma_f32_16x16x32_bf16(ldfrag(qf, CST, ti * 16, k0, lane), ldfrag(Sf, DK, vi * 16, k0, lane), acc, 0, 0, 0);
            acc = __builtin_amdgcn_mfma_f32_16x16x32_bf16(ldfrag(qb, CST, ti * 16, k0, lane), ldfrag(Sb, DK, vi * 16, k0, lane), acc, 0, 0, 0); }
#pragma unroll
        for (int j = 0; j < 4; ++j) ob[(ti * 16 + (lane >> 4) * 4 + j) * 65 + vi * 16 + (lane & 15)] = acc[j]; }
    __syncthreads();
    { const int t = tid >> 3, v0 = (tid & 7) * 8; float o[8], ss = 0.f;
#pragma unroll
      for (int i = 0; i < 8; ++i) { o[i] = ob[t * 65 + v0 + i]; ss += o[i] * o[i]; }
      ss += __shfl_xor(ss, 1); ss += __shfl_xor(ss, 2); ss += __shfl_xor(ss, 4);
      const float rstd = rsqrtf(ss * (1.f / 64.f) + 1e-6f);
      const int gcol = RET ? Z_RET + 768 + h * 64 : Z_GLA + 512 + h * 64, ycol = RET ? 512 : 768;
      const float* lng = PIN(RET ? I_RETLNG : I_GLALNG) + layer * 256 + h * 64 + v0;
      const bf16_t* gz = Z + (size_t)(row0 + t) * ZLD + gcol + v0; float r[8];
#pragma unroll
      for (int i = 0; i < 8; ++i) r[i] = o[i] * rstd * lng[i] * silu_(bf2f(gz[i]));
      u32x4 w; w.x = pk2(r[0], r[1]); w.y = pk2(r[2], r[3]); w.z = pk2(r[4], r[5]); w.w = pk2(r[6], r[7]);
      *(u32x4*)((bf16_t*)(p.ws + WS_H) + (size_t)(row0 + t) * D + ycol + h * 64 + v0) = w; }
    __syncthreads();
}

DI void phase_m1(const Params& p, int layer, unsigned char* lds) {
    for (int it = blockIdx.x; it < NROW / 16; it += gridDim.x) rwkv_prep_item(p, layer, it, lds);
}
DI void s5_prefix_task(const Params& p, int layer, int task) {
    const int n = task & 63, g = (task >> 6) & 15, dir = (task >> 10) & 1, b = task >> 11;
    const size_t e = ((size_t)(layer * 2 + dir) * 16 + g) * 64 + n; const float* abar = (const float*)(p.ws + WS_S5A);
    float pr = abar[e * 2], pi = abar[e * 2 + 1];
#pragma unroll
    for (int q = 0; q < 6; ++q) { const float nr = pr * pr - pi * pi, ni = 2.f * pr * pi; pr = nr; pi = ni; }
    float2* Eb = (float2*)(p.ws + WS_S5E) + (((size_t)b * 2 + dir) * 16 + g) * NCH * 64 + n;
    float hr = 0.f, hi = 0.f;
    for (int pos0 = 0; pos0 < NCH; pos0 += 4) { float2 ev[4];
#pragma unroll
        for (int i = 0; i < 4; ++i) ev[i] = Eb[(size_t)chunk_at(dir, pos0 + i) * 64];
#pragma unroll
        for (int i = 0; i < 4; ++i) { Eb[(size_t)chunk_at(dir, pos0 + i) * 64] = make_float2(hr, hi);
            const float nr = pr * hr - pi * hi + ev[i].x, ni = pr * hi + pi * hr + ev[i].y; hr = nr; hi = ni; } }
}
DI void convert_late(const Params& p, int layer, unsigned char* lds, int gw, int NGW) {
    asm volatile("" : "+s"(gw), "+s"(NGW));
    const int tid = otid(), wave = tid >> 6, lane = tid & 63; float* scr = (float*)(lds + wave * 8704);
    constexpr int I_OUT = 16 * 32, I_1 = 16 * 128, I_2 = 64 * 32;
    for (int it = gw * 8 + wave; it < I_OUT + I_1 + I_2; it += NGW * 8) { int r = it;
        if (r < I_OUT) { transpose_item(PIN(I_WOUT) + (size_t)layer * 1024 * 1024, 1024, 1024, 1024, (bf16_t*)(p.ws + WS_WTOUT), scr, r, lane); continue; } r -= I_OUT;
        if (r < I_1) { transpose_item(PIN(I_W1) + (size_t)layer * 1024 * 4096, 1024, 4096, 4096, (bf16_t*)(p.ws + WS_WT1), scr, r, lane); continue; } r -= I_1;
        transpose_item(PIN(I_W2) + (size_t)layer * 4096 * 1024, 4096, 1024, 1024, (bf16_t*)(p.ws + WS_WT2), scr, r, lane); }
    __syncthreads();
}
DI void sub_barrier(unsigned* cnt, unsigned target) {
    asm volatile("s_waitcnt vmcnt(0)" ::: "memory");
    __syncthreads();
    if (threadIdx.x == 0) {
        __builtin_amdgcn_fence(__ATOMIC_RELEASE, "agent"); asm volatile("s_waitcnt vmcnt(0)" ::: "memory");
        (void)__hip_atomic_fetch_add(cnt, 1u, __ATOMIC_RELAXED, __HIP_MEMORY_SCOPE_AGENT);
        unsigned sp = 0;
        while (__hip_atomic_load(cnt, __ATOMIC_RELAXED, __HIP_MEMORY_SCOPE_AGENT) < target) { __builtin_amdgcn_s_sleep(2); if (++sp > (1u << 22)) break; }
        __builtin_amdgcn_fence(__ATOMIC_ACQUIRE, "agent"); asm volatile("s_waitcnt vmcnt(0)" ::: "memory");
    }
    __syncthreads();
}
DI void phase_mix(const Params& p, int layer, unsigned char* lds, const XcdBarrier& xb) {
    if (blockIdx.x < 64) { rwkv_scan_block(p, layer, blockIdx.x, lds, xb); return; }
    const int nb = gridDim.x - 64, bi = blockIdx.x - 64; unsigned* cnt = (unsigned*)(p.ws + WS_BAR);
    { constexpr int N1 = 2080, N2 = 2 * 4 * NCH, N3 = 2 * 4 * NCH;
      for (int it = bi; it < N1 + N2 + N3; it += nb) { int r = it;
        if (r < N1) { s5_stage1_item(p, layer, r, lds); continue; } r -= N1;
        if (r < N2) { chunk_stageA<64, true>(p, layer, r, lds); continue; } r -= N2;
        chunk_stageA<32, false>(p, layer, r, lds); } }
    sub_barrier(cnt, (unsigned)nb * (unsigned)(3 * layer + 1));
    { constexpr int NB_B = (16 * 512 + 16 * 256) / 512, NB_S = 4096 / 512;
      for (int it = bi; it < NB_B + NB_S; it += nb) { const int t_ = otid();
        if (it < NB_B) { const int task = it * 512 + t_; if (task < 16 * 512) chunk_stageB_task<64, true>(p, task); else chunk_stageB_task<32, false>(p, task - 16 * 512); }
        else s5_prefix_task(p, layer, (it - NB_B) * 512 + t_); } }
    sub_barrier(cnt, (unsigned)nb * (unsigned)(3 * layer + 2));
    { constexpr int N1 = 2 * NCH, N2 = 2 * 4 * NCH, N3 = 2 * 4 * NCH;
      for (int it = bi; it < N1 + N2 + N3; it += nb) { int r = it;
        if (r < N1) { s5_stage3_item(p, layer, r, lds); continue; } r -= N1;
        if (r < N2) { chunk_stageC<64, true>(p, layer, r, lds); continue; } r -= N2;
        chunk_stageC<32, false>(p, layer, r, lds); } }
    sub_barrier(cnt, (unsigned)nb * (unsigned)(3 * layer + 3));
    for (int it = bi; it < NROW / 64; it += nb) s5_glu_item(p, layer, it, lds);
    __syncthreads();
    convert_late(p, layer, lds, bi, nb);
    if (layer < 3) mods_items(p, layer + 1, lds, bi, nb);
}
DI void phase_m3(const Params& p, int layer, unsigned char* lds) {
    for (int it = blockIdx.x; it < NROW / 8; it += gridDim.x) { const int t_ = otid(); rwkv_finish_row(p, layer, it * 8 + (t_ >> 6), t_ & 63); }
}

__global__ void __launch_bounds__(512) mk_fwd(Params p) {
    cg::grid_group grid = cg::this_grid();
    volatile LAS unsigned* xst = (volatile LAS unsigned*)(smem + LDS_MAIN);
    if (threadIdx.x == 0) { xst[0] = 0u; xst[1] = 0u;
        const float** tab = (const float**)(smem + LDS_MAIN + 64);
#pragma unroll
        for (int i = 0; i < N_IN; ++i) tab[i] = p.in[i]; }
    __syncthreads();
    const XcdBarrier xb = xcd_barrier_post((unsigned*)(p.ws + WS_BAR), xst);
    for (int ph = p.ph_lo; ph < p.ph_hi; ++ph) {
        if (ph > p.ph_lo) { if (p.ph_lo < 0) grid.sync(); else xcd_barrier(xb); }
#if PROBE_MASK & 16
        for (int q_ = 0; q_ < 2; ++q_) xcd_barrier(xb);
#endif
        if (ph == 0) { phase_pre(p, smem); if (PROBE_MASK & 32) { __syncthreads(); phase_pre(p, smem); } continue; }
        if (ph == NPHASE - 1) { if (PH_EN(101)) phase_final(p); continue; }
        const int layer = (ph - 1) / 9, sub = (ph - 1) % 9;
        const float* modl = (const float*)(p.ws + WS_MOD) + (size_t)layer * 3 * 6144;
        if (sub == 1 || sub == 5 || sub == 7 || sub == 8) {
            EpiAll E{}; const bf16_t* A; const bf16_t* Bt; int N, K;
            if (sub == 1) { E.perm = true; E.mode = 0; E.O = (bf16_t*)(p.ws + WS_Z); A = (const bf16_t*)(p.ws + WS_H); Bt = (const bf16_t*)(p.ws + WS_WTIN); N = ZPAD; K = 1024; }
            else if (sub == 7) { E.perm = true; E.mode = 1; E.O = (bf16_t*)(p.ws + WS_HID); A = (const bf16_t*)(p.ws + WS_H); Bt = (const bf16_t*)(p.ws + WS_WT1); N = DFF; K = 1024; }
            else { const bool o = sub == 5; E.perm = false; E.mode = 2; E.out = p.out; E.xctx = (float*)(p.ws + WS_XCTX); E.gate = modl + (o ? 2048 : 5120);
                A = (const bf16_t*)(p.ws + (o ? WS_H : WS_HID)); Bt = (const bf16_t*)(p.ws + (o ? WS_WTOUT : WS_WT2)); N = 1024; K = o ? 1024 : 4096; }
            { const int nrep = ((PROBE_MASK & 128) && E.mode == 2) || ((PROBE_MASK & 256) && E.mode != 2) ? 2 : 1;
              for (int rep = 0; rep < nrep; ++rep) { if (rep && E.mode == 2) E.gate = (const float*)(p.ws + WS_ZERO); run_gemm(A, Bt, (layer == 3 && sub != 1) ? NLAT : NROW, N, K, E, (PG8_LAS unsigned char*)smem); } }
            continue;
        }
        switch (sub) {
        case 0: phase_norm(p, layer, 0, smem); if (PROBE_MASK & 8) phase_norm(p, layer, 0, smem); break;
        case 2: phase_m1(p, layer, smem); if (PROBE_MASK & 4) phase_m1(p, layer, smem); break;
        case 3: phase_mix(p, layer, smem, xb); break;
        case 4: phase_m3(p, layer, smem); if (PROBE_MASK & 64) phase_m3(p, layer, smem); break;
        case 6: phase_norm(p, layer, 1, smem); if (PROBE_MASK & 8) phase_norm(p, layer, 1, smem); break;
        }
    }
}

extern "C" void kernel_launch(void* const* d_in, const int* in_sizes, int n_in, void* d_out, int out_size, void* d_ws, size_t ws_size, hipStream_t stream) {
    static int grid = 0;
    if (grid == 0) {
        if (n_in != N_IN || ws_size < WS_END) { fprintf(stderr, "kernel_launch: unexpected n_in %d / ws %zu (need %zu)\n", n_in, ws_size, (size_t)WS_END); grid = -1; return; }
        int dev = 0, cus = 0, per_cu = 0;
        hipGetDevice(&dev); hipDeviceGetAttribute(&cus, hipDeviceAttributeMultiprocessorCount, dev);
        if (hipFuncSetAttribute((const void*)mk_fwd, hipFuncAttributeMaxDynamicSharedMemorySize, LDS_BYTES) != hipSuccess) { fprintf(stderr, "kernel_launch: hipFuncSetAttribute failed\n"); grid = -1; return; }
        hipOccupancyMaxActiveBlocksPerMultiprocessor(&per_cu, (const void*)mk_fwd, 512, LDS_BYTES);
        (void)hipGetLastError();
        if (per_cu < 1) per_cu = 1;
        grid = cus * 1;
        fprintf(stderr, "kernel_launch: cus %d per_cu %d grid %d\n", cus, per_cu, grid);
    }
    if (grid < 0) return;
    Params p{};
    for (int i = 0; i < N_IN; ++i) p.in[i] = (const float*)d_in[i];
    p.out = (float*)d_out; p.ws = (unsigned char*)d_ws;
    (void)hipMemsetAsync((unsigned char*)d_ws + WS_BAR, 0, (size_t)XCD_BAR_WORDS * 4, stream);
#if MULTI_LAUNCH
    for (int ph = 0; ph < NPHASE; ++ph) { p.ph_lo = ph; p.ph_hi = ph + 1; hipLaunchKernelGGL(mk_fwd, dim3(grid), dim3(512), LDS_BYTES, stream, p); }
#else
    p.ph_lo = 0; p.ph_hi = NPHASE;
    void* args[] = {&p};
    hipError_t e = hipLaunchCooperativeKernel((const void*)mk_fwd, dim3(grid), dim3(512), args, LDS_BYTES, stream);
    if (e != hipSuccess) fprintf(stderr, "cooperative launch failed: %s (grid %d)\n", hipGetErrorString(e), grid);
#endif
}
```

```cpp
#include <hip/hip_runtime.h>
#include <hip/hip_cooperative_groups.h>
#include <cstdio>
namespace cg = cooperative_groups;
namespace pg8 {
#define PG8_LAS __attribute__((address_space(3)))
typedef unsigned short bf16_t;
typedef short bf16x8 __attribute__((ext_vector_type(8)));
typedef float f32x4 __attribute__((ext_vector_type(4)));
typedef unsigned u32x4 __attribute__((ext_vector_type(4)));
constexpr int BM = 256, BK = 64, HALF = 128, HTB = HALF * BK * 2  , STAGE_BYTES = 8 * HTB, NXCD = 8, WGM = 8;

__host__ __device__ __forceinline__ int lds_byte(int r, int c) { const int st = (r >> 4) * 2 + (c >> 5), rr = r & 15, cc = c & 31, ob = rr * 64 + cc * 2; return st * 1024 + (ob ^ (((ob >> 9) & 1) << 5)); }
__host__ __device__ __forceinline__ void stage_rc(int b, int& R, int& C) { const int st = b / 1024, sb = b % 1024, swz = sb ^ (((sb >> 9) & 1) << 5); R = (st >> 1) * 16 + swz / 64; C = (st & 1) * 32 + (swz % 64) / 2; }
__host__ __device__ __forceinline__ int perm32(int rho) { const int n = rho >> 4, i = rho & 15; return 8 * (i >> 2) + 4 * n + (i & 3); }

struct Unit { int pm, pn; };
struct Gemm { const bf16_t* A; const bf16_t* Bt; int M, N, K; };

struct StaticOrder {
    int nM, nN, nwg, G, c;
    __host__ __device__ void init(int M, int N, int G_, int c_) { nM = M / BM; nN = N / BM; nwg = nM * nN; G = G_; c = c_; }
    __host__ __device__ bool next(int i, Unit& u) const {
        const long L = (long)i * G + c; if (L >= nwg) return false;
        int wgid = (int)L; { const int q = nwg / NXCD, r = nwg % NXCD, xcd = wgid % NXCD, off = wgid / NXCD; wgid = (xcd < r ? xcd * (q + 1) : r * (q + 1) + (xcd - r) * q) + off; }
        const int nig = WGM * nN, gid = wgid / nig, fm = gid * WGM, gsz = (nM - fm) < WGM ? (nM - fm) : WGM;
        u.pm = fm + ((wgid % nig) % gsz); u.pn = (wgid % nig) / gsz; return true;
    }
    __device__ __forceinline__ void a_ready(const Unit&) const {}
    __device__ __forceinline__ void done(const Unit&) const {}
};
__device__ __forceinline__ unsigned cvt_pk_bf16(float lo, float hi) { unsigned r; asm volatile("v_cvt_pk_bf16_f32 %0, %1, %2" : "=v"(r) : "v"(lo), "v"(hi)); return r; }
template <class Epi, class Sched, bool STAMP = false>
__device__ __forceinline__ void gemm_phase(PG8_LAS unsigned char* lds, const Gemm g, const Sched& S, const Epi& E, unsigned long long* stamps) {
    int tid = threadIdx.x; asm volatile("" : "+v"(tid)); const int wid = __builtin_amdgcn_readfirstlane(tid >> 6), lane = tid & 63, wr = wid >> 2, wc = wid & 3, fr = lane & 15, fq = lane >> 4;
    const int K = g.K, nt = K / BK;
    int ts_lo = 0, ts_hi = 0, nts = 0; const unsigned long long rt_entry = STAMP ? (unsigned long long)wall_clock64() : 0ull;
#define PG8_STAMP() do { if (STAMP && wid == 0 && nts < 64) { const unsigned long long _c = (unsigned long long)clock64(); \
        ts_lo = (lane == nts) ? (int)(unsigned)_c : ts_lo; ts_hi = (lane == nts) ? (int)(unsigned)(_c >> 32) : ts_hi; ++nts; } } while (0)
    PG8_STAMP();
    unsigned voffA[2], voffB[2];
#pragma unroll
    for (int i = 0; i < 2; ++i) { int R, C; stage_rc(tid * 16 + i * 8192, R, C); const int Rb = E.perm ? ((R & ~31) + perm32(R & 31)) : R;
        voffA[i] = (unsigned)(R * K + C) * 2u; voffB[i] = (unsigned)(Rb * K + C) * 2u; }
    const size_t kstep = (size_t)(BK * 2);
    const size_t hstep = (size_t)HALF * K * 2;
    const size_t tstep = 2 * hstep;
    const unsigned ldsw = (unsigned)wid * 1024u;
    const int aoff = lds_byte(wr * 64 + fr, fq * 8), boff = lds_byte(wc * 32 + fr, fq * 8);
#define PG8_SA(b, h) (((b) * 2 + (h)) * HTB)
#define PG8_SB(b, h) ((4 + (b) * 2 + (h)) * HTB)
#define PG8_STAGE(bufoff, gbase, voff) do { _Pragma("unroll") for (int _i = 0; _i < 2; ++_i) \
        __builtin_amdgcn_global_load_lds((const unsigned*)((const char*)(gbase) + (voff)[_i]), (PG8_LAS unsigned*)(lds + (bufoff) + ldsw + _i * 8192), 16, 0, 0); } while (0)
#define PG8_LDA(dst, b, h) do { _Pragma("unroll") for (int m = 0; m < 4; ++m) _Pragma("unroll") for (int k = 0; k < 2; ++k) dst[m][k] = *(const PG8_LAS bf16x8*)(lds + PG8_SA(b, h) + aoff + m * 2048 + k * 1024); } while (0)
#define PG8_LDB(dst, b, h) do { _Pragma("unroll") for (int n = 0; n < 2; ++n) _Pragma("unroll") for (int k = 0; k < 2; ++k) dst[n][k] = *(const PG8_LAS bf16x8*)(lds + PG8_SB(b, h) + boff + n * 2048 + k * 1024); } while (0)
#define PG8_MMA(ai, bj, At, Bt) do { __builtin_amdgcn_s_setprio(1); _Pragma("unroll") for (int m = 0; m < 4; ++m) _Pragma("unroll") for (int n = 0; n < 2; ++n) _Pragma("unroll") for (int k = 0; k < 2; ++k) \
        acc[ai][bj][m][n] = __builtin_amdgcn_mfma_f32_16x16x32_bf16(Bt[n][k], At[m][k], acc[ai][bj][m][n], 0, 0, 0); __builtin_amdgcn_s_setprio(0); } while (0)
#define PG8_WAIT_V(n) asm volatile("s_waitcnt vmcnt(" #n ")" ::: "memory")
#define PG8_WAIT_L(n) asm volatile("s_waitcnt lgkmcnt(" #n ")" ::: "memory")
#define PG8_BAR __builtin_amdgcn_s_barrier()
#define PG8_SCHED __builtin_amdgcn_sched_barrier(0)
    Unit cur, nxt; int ui = 0;
    if (!S.next(0, cur)) return;
    f32x4 acc[2][2][4][2];
#pragma unroll
    for (int a = 0; a < 2; ++a)
#pragma unroll
        for (int b = 0; b < 2; ++b)
#pragma unroll
            for (int m = 0; m < 4; ++m)
#pragma unroll
                for (int n = 0; n < 2; ++n) acc[a][b][m][n] = (f32x4){0.f, 0.f, 0.f, 0.f};
    bf16x8 At[4][2], B0[2][2], B1[2][2];
    const char* cA = (const char*)g.A + (size_t)cur.pm * tstep; const char* cB = (const char*)g.Bt + (size_t)cur.pn * tstep;
    S.a_ready(cur);
    PG8_STAGE(PG8_SB(0, 0), cB, voffB); PG8_STAGE(PG8_SA(0, 0), cA, voffA); PG8_STAGE(PG8_SB(0, 1), cB + hstep, voffB); PG8_STAGE(PG8_SA(0, 1), cA + hstep, voffA);
    if (wr == 1) PG8_BAR;
    PG8_WAIT_V(4); PG8_BAR;
    PG8_STAGE(PG8_SB(1, 0), cB + kstep, voffB); PG8_STAGE(PG8_SA(1, 0), cA + kstep, voffA); PG8_STAGE(PG8_SB(1, 1), cB + hstep + kstep, voffB);
    PG8_WAIT_V(6); PG8_BAR;
    PG8_STAMP();
    for (;;) {
        const bool has_next = S.next(ui + 1, nxt);
        const char* nA = has_next ? (const char*)g.A + (size_t)nxt.pm * tstep : cA; const char* nB = has_next ? (const char*)g.Bt + (size_t)nxt.pn * tstep : cB;
        for (int t = 0; t < nt; t += 2) {
            const bool last = (t == nt - 2);
            const char* a1 = cA + (size_t)(t + 1) * kstep;
            const char* a2 = last ? nA : cA + (size_t)(t + 2) * kstep; const char* b2 = last ? nB : cB + (size_t)(t + 2) * kstep;
            const char* a3 = a2 + kstep; const char* b3 = b2 + kstep;
            if (last && has_next) S.a_ready(nxt);
            PG8_LDB(B0, 0, 0); PG8_SCHED; PG8_LDA(At, 0, 0); PG8_STAGE(PG8_SA(1, 1), a1 + hstep, voffA);
            PG8_WAIT_L(8); PG8_BAR; PG8_WAIT_L(0); PG8_MMA(0, 0, At, B0); PG8_BAR; PG8_SCHED;
            PG8_LDB(B1, 0, 1); PG8_STAGE(PG8_SB(0, 0), b2, voffB);
            PG8_BAR; PG8_WAIT_L(0); PG8_MMA(0, 1, At, B1); PG8_BAR;
            PG8_LDA(At, 0, 1); PG8_STAGE(PG8_SA(0, 0), a2, voffA);
            PG8_BAR; PG8_WAIT_L(0); PG8_MMA(1, 0, At, B0); PG8_BAR; PG8_SCHED;
            PG8_STAGE(PG8_SB(0, 1), b2 + hstep, voffB);
            PG8_WAIT_V(6); PG8_BAR; PG8_MMA(1, 1, At, B1); PG8_BAR;
            PG8_LDB(B0, 1, 0); PG8_SCHED; PG8_LDA(At, 1, 0); PG8_STAGE(PG8_SA(0, 1), a2 + hstep, voffA);
            PG8_WAIT_L(8); PG8_BAR; PG8_WAIT_L(0); PG8_MMA(0, 0, At, B0); PG8_BAR; PG8_SCHED;
            PG8_LDB(B1, 1, 1); PG8_STAGE(PG8_SB(1, 0), b3, voffB);
            PG8_BAR; PG8_WAIT_L(0); PG8_MMA(0, 1, At, B1); PG8_BAR;
            PG8_LDA(At, 1, 1); PG8_STAGE(PG8_SA(1, 0), a3, voffA);
            PG8_BAR; PG8_WAIT_L(0); PG8_MMA(1, 0, At, B0); PG8_BAR; PG8_SCHED;
            PG8_STAGE(PG8_SB(1, 1), b3 + hstep, voffB);
            PG8_WAIT_V(6); PG8_BAR; PG8_MMA(1, 1, At, B1); PG8_BAR;
        }
        PG8_STAMP();
        if constexpr (!Epi::AFTER_DRAIN) { E(acc, cur, wr, wc, fr, fq); S.done(cur); }
        PG8_STAMP();
        if (!has_next) break;
#pragma unroll
        for (int a = 0; a < 2; ++a)
#pragma unroll
            for (int b = 0; b < 2; ++b)
#pragma unroll
                for (int m = 0; m < 4; ++m)
#pragma unroll
                    for (int n = 0; n < 2; ++n) acc[a][b][m][n] = (f32x4){0.f, 0.f, 0.f, 0.f};
        cur = nxt; cA = nA; cB = nB; ++ui;
    }
    PG8_WAIT_V(0);
    if (wr == 0) PG8_BAR;
    PG8_BAR;
    if constexpr (Epi::AFTER_DRAIN) { E.fused(acc, cur, wr, wc, fr, fq, lds, wid, lane); S.done(cur); }
    PG8_STAMP();
    if (STAMP && wid == 0) { stamps[lane] = lane < nts ? (((unsigned long long)(unsigned)ts_hi << 32) | (unsigned)ts_lo) : 0ull;
        if (lane == 62) stamps[62] = rt_entry; if (lane == 63) stamps[63] = (unsigned long long)wall_clock64(); }
#undef PG8_STAMP
#undef PG8_SA
#undef PG8_SB
#undef PG8_STAGE
#undef PG8_LDA
#undef PG8_LDB
#undef PG8_MMA
#undef PG8_WAIT_V
#undef PG8_WAIT_L
#undef PG8_BAR
#undef PG8_SCHED
}
}
#define XB_TMO      128
#define XB_XCNT(j)  (256  + 64 * (j))
#define XB_XSUB(j)  (1280 + 64 * (j))
#define XB_XGEN(j)  (2304 + 64 * (j))
#define XB_TOP      3328
#define XB_TOPGEN   3392
#define XCD_BAR_WORDS 3456
#define XB_SPIN_CAP (1u << 18)
#define LAS __attribute__((address_space(3)))

__device__ __forceinline__ unsigned xb_ld(unsigned* p)              { return __hip_atomic_load(p, __ATOMIC_RELAXED, __HIP_MEMORY_SCOPE_AGENT); }
__device__ __forceinline__ unsigned xb_add(unsigned* p, unsigned v) { return __hip_atomic_fetch_add(p, v, __ATOMIC_RELAXED, __HIP_MEMORY_SCOPE_AGENT); }
__device__ __forceinline__ unsigned xb_xcc_id() { return (unsigned)__builtin_amdgcn_s_getreg((3 << 11) | 20) & 0xFu; }
#define XB_SPIN(cond, bar) do { unsigned _sp = 0; while (cond) { __builtin_amdgcn_s_sleep(1); \
    if ((++_sp & 255u) == 0u) { if (xb_ld(&(bar)[XB_TMO])) break; if (_sp > XB_SPIN_CAP) { atomicAdd(&(bar)[XB_TMO], 1u); break; } } } } while (0)

struct XcdBarrier {
    unsigned* bar; unsigned x;
    volatile LAS unsigned* st;
};

__device__ __forceinline__ XcdBarrier xcd_barrier_post(unsigned* bar, volatile LAS unsigned* st) {
    XcdBarrier b; b.bar = bar; b.x = xb_xcc_id(); b.st = st;
    if (threadIdx.x == 0) (void)xb_add(&bar[XB_XCNT(b.x)], 1u);
    return b;
}
__device__ __forceinline__ void xcd_barrier_complete(unsigned* bar, unsigned x, unsigned& nloc, unsigned& nx) {
    const unsigned G = gridDim.x * gridDim.y * gridDim.z;
    unsigned sum, cnt, mine, sp = 0u;
    for (;;) {
        sum = 0u; cnt = 0u; mine = 0u;
#pragma unroll
        for (unsigned j = 0; j < 16; ++j) { const unsigned c = xb_ld(&bar[XB_XCNT(j)]); sum += c; cnt += (c > 0u) ? 1u : 0u; mine = (j == x) ? c : mine; }
        if (sum == G) break;
        __builtin_amdgcn_s_sleep(1);
        if ((++sp & 255u) == 0u) { if (xb_ld(&bar[XB_TMO])) break; if (sp > XB_SPIN_CAP) { atomicAdd(&bar[XB_TMO], 1u); break; } }
    }
    nloc = mine > 0u ? mine : 1u; nx = cnt > 0u ? cnt : 1u;
}

__device__ __forceinline__ void xcd_barrier(const XcdBarrier& b) {
    asm volatile("s_waitcnt vmcnt(0)" ::: "memory");
    __syncthreads();
    if (threadIdx.x == 0) {
        unsigned* bar = b.bar;
        __builtin_amdgcn_s_waitcnt(0);
        unsigned nloc = b.st[0], nx = b.st[1];
        if (nloc == 0u) { xcd_barrier_complete(bar, b.x, nloc, nx); b.st[0] = nloc; b.st[1] = nx; }
        const unsigned old = xb_add(&bar[XB_XSUB(b.x)], 1u);
        const unsigned gen = old / nloc;
        if (old + 1u == (gen + 1u) * nloc) {
            __builtin_amdgcn_fence(__ATOMIC_RELEASE, "agent");
            asm volatile("s_waitcnt vmcnt(0)" ::: "memory");
            const unsigned og = xb_add(&bar[XB_TOP], 1u);
            const unsigned tg = og / nx;
            if (og + 1u == (tg + 1u) * nx) xb_add(&bar[XB_TOPGEN], 1u);
            else XB_SPIN(xb_ld(&bar[XB_TOPGEN]) == tg, bar);
            __builtin_amdgcn_fence(__ATOMIC_ACQUIRE, "agent");
            xb_add(&bar[XB_XGEN(b.x)], 1u);
            asm volatile("s_waitcnt vmcnt(0)" ::: "memory");
        } else {
            XB_SPIN(xb_ld(&bar[XB_XGEN(b.x)]) == gen, bar);
            __builtin_amdgcn_fence(__ATOMIC_ACQUIRE, "agent");
            asm volatile("s_waitcnt vmcnt(0)" ::: "memory");
        }
    }
    __syncthreads();
}

using pg8::bf16_t; using pg8::bf16x8; using pg8::f32x4; using pg8::u32x4;
#define DI __device__ __forceinline__
#ifndef DBG_ONLY
#define DBG_ONLY -1
#endif
#define PH_EN(x) (DBG_ONLY < 0 || DBG_ONLY == (x))
#ifndef PROBE_MASK
#define PROBE_MASK 0
#endif
#ifndef MULTI_LAUNCH
#define MULTI_LAUNCH 0
#endif

enum { I_X = 0, I_C, I_CTX, I_CCTX, I_ADAW, I_ADAB, I_N1G, I_N2G, I_WIN, I_WOUT,
       I_S5LRE, I_S5LIM, I_S5LDT, I_S5BRE, I_S5BIM, I_S5CRE, I_S5CIM, I_S5D, I_S5GW, I_S5GB,
       I_RWMU, I_RWW0, I_RWWUP, I_RWA0, I_RWAUP, I_RWGUP, I_RWKK, I_RWKA, I_RWRK, I_RWLNG, I_RWLNB,
       I_RETDEC, I_RETLNG, I_GLAAUP, I_GLAAB, I_GLALNG, I_W1, I_W2, I_FING, N_IN };

struct Params { const float* in[N_IN]; float* out; unsigned char* ws; int ph_lo, ph_hi; };
extern __shared__ __attribute__((aligned(16))) unsigned char smem[];

constexpr int D = 1024, NB = 2, SEQ = 16384, CTXL = 256;
constexpr int NLAT = NB * SEQ, NROW = NLAT + NB * CTXL;
constexpr int ZLD = 2960, ZPAD = 3072, DFF = 4096, NCH = 260;
constexpr int Z_RW = 256, Z_RET = 1152, Z_GLA = 2176;
constexpr int LDS_MAIN = 144 * 1024;
constexpr int LDS_BYTES = LDS_MAIN + 1024;
#define PIN(i) (((const float* const*)(smem + LDS_MAIN + 64))[(i)])
constexpr int NPHASE = 38;

constexpr size_t al256(size_t x) { return (x + 255) & ~(size_t)255; }
constexpr size_t WS_MOD   = 0;
constexpr size_t WS_S5A   = al256(WS_MOD + (size_t)4 * 3 * 6144 * 4);
constexpr size_t WS_S5B   = al256(WS_S5A + (size_t)4 * 2 * 16 * 64 * 2 * 4);
constexpr size_t WS_XCTX  = al256(WS_S5B + (size_t)4 * 2 * 16 * 64 * 16 * 2 * 4);
constexpr size_t WS_WTIN  = al256(WS_XCTX + (size_t)512 * 1024 * 4);
constexpr size_t WS_WTOUT = al256(WS_WTIN + (size_t)ZPAD * 1024 * 2);
constexpr size_t WS_WT1   = al256(WS_WTOUT + (size_t)1024 * 1024 * 2);
constexpr size_t WS_WT2   = al256(WS_WT1 + (size_t)4096 * 1024 * 2);
constexpr size_t WS_WTGLU = al256(WS_WT2 + (size_t)4096 * 1024 * 2);
constexpr size_t WS_H     = al256(WS_WTGLU + (size_t)256 * 256 * 2);
constexpr size_t WS_S5E   = al256(WS_H + (size_t)NROW * 1024 * 2);
constexpr size_t WS_DECR  = al256(WS_S5E + (size_t)2 * 2 * 16 * NCH * 64 * 2 * 4);
constexpr size_t WS_DECG  = al256(WS_DECR + (size_t)16 * NCH * 64 * 4);
constexpr size_t WS_CSR   = al256(WS_DECG + (size_t)16 * NCH * 32 * 4);
constexpr size_t WS_CSG   = al256(WS_CSR + (size_t)16 * NCH * 64 * 64 * 2);
constexpr size_t WS_Z     = al256(WS_CSG + (size_t)16 * NCH * 64 * 32 * 2);
constexpr size_t WS_RWOP  = al256(WS_Z + (size_t)NROW * ZLD * 2);
constexpr int RWLD = 2560;
constexpr size_t WS_BON   = al256(WS_RWOP + (size_t)NROW * RWLD * 2);
constexpr size_t WS_ROPE  = al256(WS_BON + (size_t)NROW * 4 * 4);
constexpr size_t WS_RWT   = al256(WS_ROPE + (size_t)(256 + 64) * 16 * 8);
constexpr size_t WS_CM    = al256(WS_RWT + (size_t)(4 * 8192 + 16384) * 2);
constexpr size_t WS_ZERO  = al256(WS_CM + (size_t)4 * 2 * 16 * 16 * 128 * 2);
constexpr size_t WS_BAR   = al256(WS_ZERO + (size_t)3 * 6144 * 4);
constexpr size_t WS_END   = al256(WS_BAR + (size_t)XCD_BAR_WORDS * 4);
constexpr size_t WS_HID   = WS_Z;
static_assert((size_t)NROW * DFF * 2 <= WS_END - WS_Z, "hidden alias");

DI int otid() { int t = threadIdx.x; asm volatile("" : "+v"(t)); return t; }
DI float bf2f(bf16_t b) { return __uint_as_float(((unsigned)b) << 16); }
DI bf16_t f2bf(float f) { unsigned u = __float_as_uint(f); u += 0x7FFFu + ((u >> 16) & 1u); return (bf16_t)(u >> 16); }
DI unsigned pk2(float lo, float hi) { return (unsigned)f2bf(lo) | ((unsigned)f2bf(hi) << 16); }
DI float wave_sum(float v) {
#pragma unroll
    for (int o = 1; o < 64; o <<= 1) v += __shfl_xor(v, o);
    return v;
}
DI float sigmoid_(float x) { return 1.f / (1.f + __expf(-x)); }
DI float softplus_(float x) { return fmaxf(x, 0.f) + log1pf(__expf(-fabsf(x))); }
DI float logsigmoid_(float x) { return -softplus_(-x); }
DI float silu_(float x) { return x * sigmoid_(x); }
DI float gelu_tanh_(float x) { const float u = 0.7978845608028654f * (x + 0.044715f * x * x * x); return 0.5f * x * (1.f + tanhf(u)); }
#define WAVE_LDS_SYNC() asm volatile("s_waitcnt lgkmcnt(0)" ::: "memory")

DI float* xrow(const Params& p, int row) { return row < NLAT ? p.out + (size_t)row * D : (float*)(p.ws + WS_XCTX) + (size_t)(row - NLAT) * D; }
DI int chunk_row0(int b, int ci) { return ci < 4 ? NLAT + b * CTXL + ci * 64 : b * SEQ + (ci - 4) * 64; }
DI int chunk_at(int dir, int pos) { return dir == 0 ? pos : (pos < 4 ? 3 - pos : 263 - pos); }
DI int modset(int row) { return row < SEQ ? 0 : (row < NLAT ? 1 : 2); }

struct EpiZ {
    static constexpr bool PERM = true, AFTER_DRAIN = false;
    bf16_t* O;
    DI void operator()(const f32x4 (&acc)[2][2][4][2], const pg8::Unit& u, int wr, int wc, int fr, int fq) const {
        const int row0 = u.pm * 256 + wr * 64 + fr, col0 = u.pn * 256 + wc * 32 + 8 * fq;
#pragma unroll
        for (int ai = 0; ai < 2; ++ai)
#pragma unroll
            for (int m = 0; m < 4; ++m) { bf16_t* rowp = O + (size_t)(row0 + ai * 128 + m * 16) * ZLD + col0;
#pragma unroll
                for (int bj = 0; bj < 2; ++bj) { if (col0 + bj * 128 < ZLD) { const f32x4 v0 = acc[ai][bj][m][0], v1 = acc[ai][bj][m][1];
                    u32x4 w; w.x = pg8::cvt_pk_bf16(v0[0], v0[1]); w.y = pg8::cvt_pk_bf16(v0[2], v0[3]); w.z = pg8::cvt_pk_bf16(v1[0], v1[1]); w.w = pg8::cvt_pk_bf16(v1[2], v1[3]);
                    *(u32x4*)(rowp + bj * 128) = w; } } }
    }
};
struct EpiSq {
    static constexpr bool PERM = true, AFTER_DRAIN = false;
    bf16_t* O;
    DI void operator()(const f32x4 (&acc)[2][2][4][2], const pg8::Unit& u, int wr, int wc, int fr, int fq) const {
        const int row0 = u.pm * 256 + wr * 64 + fr, col0 = u.pn * 256 + wc * 32 + 8 * fq;
#pragma unroll
        for (int ai = 0; ai < 2; ++ai)
#pragma unroll
            for (int m = 0; m < 4; ++m) { bf16_t* rowp = O + (size_t)(row0 + ai * 128 + m * 16) * DFF + col0;
#pragma unroll
                for (int bj = 0; bj < 2; ++bj) { f32x4 v0 = acc[ai][bj][m][0], v1 = acc[ai][bj][m][1];
#pragma unroll
                    for (int j = 0; j < 4; ++j) { const float a = fmaxf(v0[j], 0.f), b = fmaxf(v1[j], 0.f); v0[j] = a * a; v1[j] = b * b; }
                    u32x4 w; w.x = pg8::cvt_pk_bf16(v0[0], v0[1]); w.y = pg8::cvt_pk_bf16(v0[2], v0[3]); w.z = pg8::cvt_pk_bf16(v1[0], v1[1]); w.w = pg8::cvt_pk_bf16(v1[2], v1[3]);
                    *(u32x4*)(rowp + bj * 128) = w; } }
    }
};
struct EpiRes {
    static constexpr bool PERM = false, AFTER_DRAIN = false;
    float* out; float* xctx; const float* gate;
    DI void operator()(const f32x4 (&acc)[2][2][4][2], const pg8::Unit& u, int wr, int wc, int fr, int fq) const {
        const int row0 = u.pm * 256 + wr * 64 + fr, col0 = u.pn * 256 + wc * 32 + 4 * fq;
        const int set = u.pm < 64 ? 0 : (u.pm < 128 ? 1 : 2);
        const float* gp = gate + set * 6144 + col0;
        f32x4 gv[2][2];
#pragma unroll
        for (int bj = 0; bj < 2; ++bj)
#pragma unroll
            for (int n = 0; n < 2; ++n) gv[bj][n] = *(const f32x4*)(gp + bj * 128 + n * 16);
#pragma unroll
        for (int ai = 0; ai < 2; ++ai)
#pragma unroll
            for (int m = 0; m < 4; ++m) { const int row = row0 + ai * 128 + m * 16;
                float* xr = (row < NLAT ? out + (size_t)row * D : xctx + (size_t)(row - NLAT) * D) + col0;
#pragma unroll
                for (int bj = 0; bj < 2; ++bj)
#pragma unroll
                    for (int n = 0; n < 2; ++n) { f32x4* px = (f32x4*)(xr + bj * 128 + n * 16); f32x4 xv = *px; xv = xv + gv[bj][n] * acc[ai][bj][m][n]; *px = xv; } }
    }
};
struct EpiAll {
    static constexpr bool AFTER_DRAIN = false;
    bool perm; int mode; bf16_t* O; float* out; float* xctx; const float* gate;
    DI void operator()(const f32x4 (&acc)[2][2][4][2], const pg8::Unit& u, int wr, int wc, int fr, int fq) const {
        if (mode == 0) { EpiZ e{O}; e(acc, u, wr, wc, fr, fq); }
        else if (mode == 1) { EpiSq e{O}; e(acc, u, wr, wc, fr, fq); }
        else { EpiRes e{out, xctx, gate}; e(acc, u, wr, wc, fr, fq); }
    }
};
template <class Epi> DI void run_gemm(const bf16_t* A, const bf16_t* Bt, int M, int N, int K, const Epi& E, PG8_LAS unsigned char* lds) {
    pg8::Gemm g{A, Bt, M, N, K}; pg8::StaticOrder S; S.init(M, N, (int)gridDim.x, (int)blockIdx.x);
    pg8::gemm_phase<Epi, pg8::StaticOrder, false>(lds, g, S, E, nullptr);
}

DI void mods_items(const Params& p, int layer, unsigned char* lds, int first, int stride) {
    const int tid = otid();
    float* cond = (float*)lds; float* red = cond + 3 * 1024; float* mod = (float*)(p.ws + WS_MOD);
    if (first >= 96) return;
    for (int i = tid; i < 3072; i += 512) { const int set = i >> 10, k = i & 1023; const float cv = set < 2 ? PIN(I_C)[set * 1024 + k] : PIN(I_CCTX)[k]; cond[i] = silu_(cv); }
    __syncthreads();
    for (int cb = first; cb < 96; cb += stride) {
        const int ks = tid >> 6, c = tid & 63;
        const float* W = PIN(I_ADAW) + (size_t)layer * 1024 * 6144 + cb * 64 + c;
        float a0 = 0.f, a1 = 0.f, a2 = 0.f;
#pragma unroll 8
        for (int k = ks * 128; k < ks * 128 + 128; ++k) { const float w = W[(size_t)k * 6144]; a0 += cond[k] * w; a1 += cond[1024 + k] * w; a2 += cond[2048 + k] * w; }
        red[(ks * 3 + 0) * 64 + c] = a0; red[(ks * 3 + 1) * 64 + c] = a1; red[(ks * 3 + 2) * 64 + c] = a2;
        __syncthreads();
        if (tid < 192) { const int set = tid >> 6, cc = tid & 63; float s = PIN(I_ADAB)[layer * 6144 + cb * 64 + cc];
            for (int q = 0; q < 8; ++q) s += red[(q * 3 + set) * 64 + cc];
            mod[(size_t)(layer * 3 + set) * 6144 + cb * 64 + cc] = s; }
        __syncthreads();
    }
}
DI void phase_pre(const Params& p, unsigned char* lds) {
    const int tid = otid(); const size_t nthr = (size_t)gridDim.x * 512, gtid = (size_t)blockIdx.x * 512 + tid;
    {
      const float4* s2 = (const float4*)PIN(I_CTX); float4* d2 = (float4*)(p.ws + WS_XCTX); for (size_t i = gtid; i < (size_t)512 * D / 4; i += nthr) d2[i] = s2[i]; }
    { float* abar = (float*)(p.ws + WS_S5A); float* bbar = (float*)(p.ws + WS_S5B);
      for (size_t e = gtid; e < (size_t)4 * 2 * 16 * 64; e += nthr) {
        const float lr = fminf(PIN(I_S5LRE)[e], -1e-4f), li = PIN(I_S5LIM)[e], dt = expf(PIN(I_S5LDT)[e >> 6]);
        const float th = li * dt; float sn, cs; sincosf(th, &sn, &cs); const float em = expm1f(lr * dt), sh = sinf(0.5f * th);
        const float ar = (em + 1.f) * cs, ai = (em + 1.f) * sn; const float nr = em * cs - 2.f * sh * sh, ni = ai;
        const float den = 1.f / (lr * lr + li * li); const float qr = (nr * lr + ni * li) * den, qi = (ni * lr - nr * li) * den;
        abar[e * 2] = ar; abar[e * 2 + 1] = ai;
        for (int pp = 0; pp < 16; ++pp) { const float br = PIN(I_S5BRE)[e * 16 + pp], bi = PIN(I_S5BIM)[e * 16 + pp];
            bbar[(e * 16 + pp) * 2] = qr * br - qi * bi; bbar[(e * 16 + pp) * 2 + 1] = qr * bi + qi * br; } }
      bf16_t* cm = (bf16_t*)(p.ws + WS_CM);
      for (size_t e = gtid; e < (size_t)4 * 2 * 16 * 16 * 64; e += nthr) { const size_t gdp = e >> 6; const int n = (int)(e & 63);
        cm[gdp * 128 + 2 * n] = f2bf(PIN(I_S5CRE)[e]); cm[gdp * 128 + 2 * n + 1] = f2bf(-PIN(I_S5CIM)[e]); } }
    { float2* rope = (float2*)(p.ws + WS_ROPE);
      for (size_t e = gtid; e < (size_t)(256 + 64) * 16; e += nthr) { const int f = (int)(e & 15); const float pos = (float)(e < 4096 ? (e >> 4) : ((e - 4096) >> 4));
        const float inv = expf(-(float)f * (9.210340371976184f / 16.f)); float sn, cs; sincosf(pos * inv, &sn, &cs); rope[e] = make_float2(cs, sn); } }
    { float* zz = (float*)(p.ws + WS_ZERO); for (size_t e = gtid; e < (size_t)3 * 6144; e += nthr) zz[e] = 0.f; }
    mods_items(p, 0, lds, blockIdx.x, gridDim.x);
}

DI void transpose_item(const float* W, int K, int N, int Npad, bf16_t* WT, float* scr, int item, int lane) {
    const int nblk = Npad / 32, kb = item / nblk, nb = item % nblk, k0 = 64 * kb, n0 = 32 * nb;
    const int n = n0 + (lane & 31);
#pragma unroll 8
    for (int i = 0; i < 32; ++i) { const int kk = 2 * i + (lane >> 5); scr[kk * 33 + (lane & 31)] = n < N ? W[(size_t)(k0 + kk) * N + n] : 0.f; }
    WAVE_LDS_SYNC();
    const int c = lane & 7;
#pragma unroll
    for (int j = 0; j < 4; ++j) { const int nn = (lane >> 3) + 8 * j; const float* s = scr + (8 * c) * 33 + nn;
        u32x4 o; o.x = pk2(s[0 * 33], s[1 * 33]); o.y = pk2(s[2 * 33], s[3 * 33]); o.z = pk2(s[4 * 33], s[5 * 33]); o.w = pk2(s[6 * 33], s[7 * 33]);
        *(u32x4*)(WT + (size_t)(n0 + nn) * K + k0 + 8 * c) = o; }
    WAVE_LDS_SYNC();
}
DI void phase_norm(const Params& p, int layer, int which, unsigned char* lds) {
    const int nrows = (layer == 3 && which == 1) ? NLAT : NROW;
    const int tid = otid(), wave = tid >> 6, lane = tid & 63, gw = blockIdx.x * 8 + wave, NGW = gridDim.x * 8;
    if (which == 0) {
        float* scr = (float*)(lds + wave * 8704);
        constexpr int I_IN = 16 * 96, I_G = 4 * 8;
        for (int it = gw; it < I_IN + I_G; it += NGW) {
            int r = it;
            if (r < I_IN) { transpose_item(PIN(I_WIN) + (size_t)layer * 1024 * ZLD, 1024, ZLD, ZPAD, (bf16_t*)(p.ws + WS_WTIN), scr, r, lane); continue; } r -= I_IN;
            transpose_item(PIN(I_S5GW) + (size_t)layer * 256 * 256, 256, 256, 256, (bf16_t*)(p.ws + WS_WTGLU), scr, r, lane);
        }
    }
    if (which == 0) {
        bf16_t* rwt = (bf16_t*)(p.ws + WS_RWT); const int gt = blockIdx.x * 512 + tid, ngt = gridDim.x * 512;
        for (int i = gt; i < 4 * 8192 + 16384; i += ngt) {
            if (i < 4 * 8192) { const int m = i >> 13, r = i & 8191, c = r >> 5, k = r & 31;
                const float* src = (m < 2 ? PIN(I_RWWUP) : PIN(I_RWAUP)) + (size_t)(layer * 2 + (m & 1)) * 32 * 256; rwt[i] = f2bf(src[k * 256 + c]); }
            else { const int r = i - 4 * 8192, c = r >> 6, k = r & 63; rwt[i] = f2bf(PIN(I_RWGUP)[(size_t)layer * 64 * 256 + k * 256 + c]); } }
    }
    const float* gam = PIN(which == 0 ? I_N1G : I_N2G) + layer * 1024;
    const float* modl = (const float*)(p.ws + WS_MOD) + (size_t)layer * 3 * 6144 + (which == 0 ? 0 : 3072);
    bf16_t* H = (bf16_t*)(p.ws + WS_H);
    for (int row = gw; row < nrows; row += NGW) {
        const bool first = layer == 0 && which == 0 && row < NLAT;
        const float* xr = first ? PIN(I_X) + (size_t)row * D : xrow(p, row); const float* sh = modl + modset(row) * 6144; const float* sc = sh + 1024;
        float4 v[4]; float ss = 0.f;
#pragma unroll
        for (int j = 0; j < 4; ++j) { v[j] = *(const float4*)(xr + 4 * lane + 256 * j); ss += v[j].x * v[j].x + v[j].y * v[j].y + v[j].z * v[j].z + v[j].w * v[j].w; }
        if (first) {
#pragma unroll
            for (int j = 0; j < 4; ++j) *(float4*)(p.out + (size_t)row * D + 4 * lane + 256 * j) = v[j]; }
        const float rstd = rsqrtf(wave_sum(ss) * (1.f / 1024.f) + 1e-6f);
#pragma unroll
        for (int j = 0; j < 4; ++j) { const int c = 4 * lane + 256 * j; const float4 g = *(const float4*)(gam + c), s1 = *(const float4*)(sc + c), s0 = *(const float4*)(sh + c);
            const float o0 = v[j].x * rstd * g.x * (1.f + s1.x) + s0.x, o1 = v[j].y * rstd * g.y * (1.f + s1.y) + s0.y, o2 = v[j].z * rstd * g.z * (1.f + s1.z) + s0.z, o3 = v[j].w * rstd * g.w * (1.f + s1.w) + s0.w;
            uint2 w; w.x = pk2(o0, o1); w.y = pk2(o2, o3); *(uint2*)(H + (size_t)row * D + c) = w; }
    }
}
DI void phase_final(const Params& p) {
    const int tid = otid(), wave = tid >> 6, lane = tid & 63, gw = blockIdx.x * 8 + wave, NGW = gridDim.x * 8;
    const float* gam = PIN(I_FING);
    for (int row = gw; row < NLAT; row += NGW) {
        float* xr = p.out + (size_t)row * D; float4 v[4]; float ss = 0.f;
#pragma unroll
        for (int j = 0; j < 4; ++j) { v[j] = *(const float4*)(xr + 4 * lane + 256 * j); ss += v[j].x * v[j].x + v[j].y * v[j].y + v[j].z * v[j].z + v[j].w * v[j].w; }
        const float rstd = rsqrtf(wave_sum(ss) * (1.f / 1024.f) + 1e-6f);
#pragma unroll
        for (int j = 0; j < 4; ++j) { const int c = 4 * lane + 256 * j; const float4 g = *(const float4*)(gam + c);
            float4 o; o.x = v[j].x * rstd * g.x; o.y = v[j].y * rstd * g.y; o.z = v[j].z * rstd * g.z; o.w = v[j].w * rstd * g.w; *(float4*)(xr + c) = o; }
    }
}

DI bf16x8 ldfrag(const bf16_t* base, int stride, int r0, int k0, int lane);
DI void rwkv_prep_item(const Params& p, int layer, int item, unsigned char* lds) {
    const int tid = otid(), wave = tid >> 6, lane = tid & 63, row0 = item * 16;
    float* zm = (float*)lds;
    bf16_t* TW = (bf16_t*)(lds + 57344);
    bf16_t* AL = TW + 16 * 40;
    bf16_t* SG = AL + 16 * 40;
    float* SS = (float*)(lds + 57344 + 8192);
    const bf16_t* Z = (const bf16_t*)(p.ws + WS_Z);
    const float* mu = PIN(I_RWMU) + layer * 896;
    for (int idx = tid; idx < 16 * 112; idx += 512) {
        const int rr = idx / 112, c0 = (idx % 112) * 8, row = row0 + rr; int nrow = -1;
        if (row >= NLAT) { const int t = (row - NLAT) & 255; if (c0 < 448) { if (t > 0) nrow = row - 1; } else { if (t < 255) nrow = row + 1; } }
        else { const int tl = row & (SEQ - 1), col = tl & 63, gr = tl >> 6;
            if (c0 < 224) { if (col > 0) nrow = row - 1; } else if (c0 < 448) { if (col < 63) nrow = row + 1; } else if (c0 < 672) { if (gr > 0) nrow = row - 64; } else { if (gr < 255) nrow = row + 64; } }
        const u32x4 zq = *(const u32x4*)(Z + (size_t)row * ZLD + Z_RW + c0);
        u32x4 nq = {0u, 0u, 0u, 0u}; if (nrow >= 0) nq = *(const u32x4*)(Z + (size_t)nrow * ZLD + Z_RW + c0);
        const float4 m0 = *(const float4*)(mu + c0), m1 = *(const float4*)(mu + c0 + 4);
        const unsigned zw[4] = {zq.x, zq.y, zq.z, zq.w}, nw[4] = {nq.x, nq.y, nq.z, nq.w}; const float mm[8] = {m0.x, m0.y, m0.z, m0.w, m1.x, m1.y, m1.z, m1.w}; float o[8];
#pragma unroll
        for (int i = 0; i < 4; ++i) { const float z0 = __uint_as_float(zw[i] << 16), z1 = __uint_as_float(zw[i] & 0xFFFF0000u), s0 = __uint_as_float(nw[i] << 16), s1 = __uint_as_float(nw[i] & 0xFFFF0000u);
            o[2 * i] = z0 + mm[2 * i] * (s0 - z0); o[2 * i + 1] = z1 + mm[2 * i + 1] * (s1 - z1); }
        *(float4*)(zm + rr * 896 + c0) = make_float4(o[0], o[1], o[2], o[3]); *(float4*)(zm + rr * 896 + c0 + 4) = make_float4(o[4], o[5], o[6], o[7]);
    }
    __syncthreads();
    float* bon = (float*)(p.ws + WS_BON);
    for (int idx = tid; idx < 16 * 128; idx += 512) { const int rr = idx >> 7, j = idx & 127;
        if (j < 32) TW[rr * 40 + j] = f2bf(tanhf(zm[rr * 896 + 768 + j])); else if (j < 64) AL[rr * 40 + (j - 32)] = f2bf(zm[rr * 896 + 800 + (j - 32)]); else SG[rr * 72 + (j - 64)] = f2bf(sigmoid_(zm[rr * 896 + 832 + (j - 64)])); }
    { const int rr = tid >> 5, hd = (tid >> 3) & 3, part = tid & 7; float ss = 0.f, bs = 0.f;
#pragma unroll
      for (int i = 0; i < 8; ++i) { const int c = hd * 64 + part * 8 + i; const float r = zm[rr * 896 + c], k = zm[rr * 896 + 256 + c]; const float kkv = k * PIN(I_RWKK)[layer * 256 + c]; ss += kkv * kkv; bs += r * k * PIN(I_RWRK)[layer * 256 + c]; }
      ss += __shfl_xor(ss, 1); ss += __shfl_xor(ss, 2); ss += __shfl_xor(ss, 4); bs += __shfl_xor(bs, 1); bs += __shfl_xor(bs, 2); bs += __shfl_xor(bs, 4);
      if (part == 0) { SS[rr * 4 + hd] = ss; bon[(size_t)(row0 + rr) * 4 + hd] = bs; } }
    __syncthreads();
    const bf16_t* rwt = (const bf16_t*)(p.ws + WS_RWT); bf16_t* op = (bf16_t*)(p.ws + WS_RWOP);
    const int quad = lane >> 4, col = lane & 15;
    const bf16x8 twf = ldfrag(TW, 40, 0, 0, lane), alf = ldfrag(AL, 40, 0, 0, lane), sg0 = ldfrag(SG, 72, 0, 0, lane), sg1 = ldfrag(SG, 72, 0, 32, lane);
#pragma unroll 1
    for (int ci = 0; ci < 2; ++ci) { const int c = (wave * 2 + ci) * 16 + col;
        const f32x4 z4 = {0.f, 0.f, 0.f, 0.f};
        const f32x4 w0 = __builtin_amdgcn_mfma_f32_16x16x32_bf16(twf, *(const bf16x8*)(rwt + 0 * 8192 + c * 32 + quad * 8), z4, 0, 0, 0);
        const f32x4 w1 = __builtin_amdgcn_mfma_f32_16x16x32_bf16(twf, *(const bf16x8*)(rwt + 1 * 8192 + c * 32 + quad * 8), z4, 0, 0, 0);
        const f32x4 a0 = __builtin_amdgcn_mfma_f32_16x16x32_bf16(alf, *(const bf16x8*)(rwt + 2 * 8192 + c * 32 + quad * 8), z4, 0, 0, 0);
        const f32x4 a1 = __builtin_amdgcn_mfma_f32_16x16x32_bf16(alf, *(const bf16x8*)(rwt + 3 * 8192 + c * 32 + quad * 8), z4, 0, 0, 0);
        f32x4 gg = __builtin_amdgcn_mfma_f32_16x16x32_bf16(sg0, *(const bf16x8*)(rwt + 4 * 8192 + c * 64 + quad * 8), z4, 0, 0, 0);
        gg = __builtin_amdgcn_mfma_f32_16x16x32_bf16(sg1, *(const bf16x8*)(rwt + 4 * 8192 + c * 64 + 32 + quad * 8), gg, 0, 0, 0);
        const float kk_ = PIN(I_RWKK)[layer * 256 + c], ka_ = PIN(I_RWKA)[layer * 256 + c];
        const float w00 = PIN(I_RWW0)[(layer * 2 + 0) * 256 + c], w01 = PIN(I_RWW0)[(layer * 2 + 1) * 256 + c];
        const float a00 = PIN(I_RWA0)[(layer * 2 + 0) * 256 + c], a01 = PIN(I_RWA0)[(layer * 2 + 1) * 256 + c];
#pragma unroll
        for (int j = 0; j < 4; ++j) { const int rr = quad * 4 + j; bf16_t* o = op + (size_t)(row0 + rr) * RWLD + c;
            const float r = zm[rr * 896 + c], k = zm[rr * 896 + 256 + c], v = zm[rr * 896 + 512 + c];
            const float kk = k * kk_ * rsqrtf(SS[rr * 4 + (c >> 6)] + 1e-12f);
            const float x0 = -(w00 + w0[j]), x1 = -(w01 + w1[j]);
            const float wr0 = -(fmaxf(x0, 0.f) + __logf(1.f + __expf(-fabsf(x0)))) - 0.5f, wr1 = -(fmaxf(x1, 0.f) + __logf(1.f + __expf(-fabsf(x1)))) - 0.5f;
            const float e0 = __expf(wr0), e1 = __expf(wr1);
            const float om0 = -expm1f(-e0), om1 = -expm1f(-e1);
            const float as0 = sigmoid_(a00 + a0[j]), as1 = sigmoid_(a01 + a1[j]);
            o[0] = f2bf(r); o[256] = f2bf(v); o[512] = f2bf(-kk);
            o[768] = f2bf(om0); o[1024] = f2bf(k * (1.f + (as0 - 1.f) * ka_)); o[1280] = f2bf(kk * as0);
            o[1536] = f2bf(om1); o[1792] = f2bf(k * (1.f + (as1 - 1.f) * ka_)); o[2048] = f2bf(kk * as1);
            o[2304] = f2bf(gg[j]); }
    }
    __syncthreads();
}
DI int rw_row(int b, int dir, int pp) { if (pp < 256) return NLAT + b * CTXL + (dir ? 255 - pp : pp); const int q = pp - 256; return b * SEQ + (dir ? SEQ - 1 - q : q); }
template <int CTRL> DI float dpp_(float x) { return __int_as_float(__builtin_amdgcn_update_dpp(0, __float_as_int(x), CTRL, 0xf, 0xf, false)); }
DI float row16_allsum(float x) { x += dpp_<0x128>(x); x += dpp_<0x124>(x); x += dpp_<0x122>(x); x += dpp_<0x121>(x); return x; }
typedef float f32x2_ __attribute__((ext_vector_type(2)));
#ifndef SCAN_SYNC1
#define SCAN_SYNC1 170
#define SCAN_SYNC2 340
#endif
DI void rwkv_scan_block(const Params& p, int layer, int blk, unsigned char* lds, const XcdBarrier& xb) {
    const int tid = otid(), chain = blk >> 2, b = chain >> 3, dir = (chain >> 2) & 1, h = chain & 3, vbase = (blk & 3) * 16;
    constexpr int SST = 352;
    float* buf = (float*)lds;
    float* ybuf = buf + 2 * 32 * SST;
    const bf16_t* op = (const bf16_t*)(p.ws + WS_RWOP);
    bf16_t* Z = (bf16_t*)(p.ws + WS_Z);
    const bool loader = tid >= 256; const int lt = tid - 256;
    const int NBATCH = (256 + SEQ) / 32;
    const int lj = lt >> 3, part = lt & 7;
    u32x4 raw[6];
#pragma unroll
    for (int i = 0; i < 6; ++i) raw[i] = (u32x4){0u, 0u, 0u, 0u};
    auto gload = [&](int nb) {
        const int pp = nb * 32 + lj; const int pn = pp + 1 < 256 + SEQ ? pp + 1 : pp;
        const bf16_t* base = op + (size_t)rw_row(b, dir, pp) * RWLD + h * 64 + part * 8;
        raw[0] = *(const u32x4*)(base + 768 + dir * 768); raw[1] = *(const u32x4*)(base + 1024 + dir * 768);
        raw[2] = *(const u32x4*)(op + (size_t)rw_row(b, dir, pn) * RWLD + h * 64 + part * 8 + 512);
        raw[3] = *(const u32x4*)(base + 1280 + dir * 768); raw[4] = *(const u32x4*)(base); raw[5] = *(const u32x4*)(base + 256);
    };
    auto lwrite = [&](int nb) {
        float* dst = buf + (nb & 1) * (32 * SST) + lj * SST + part * 8;
        float4 lo[6], hi[6];
#pragma unroll
        for (int i = 0; i < 6; ++i) { const u32x4 q = raw[i];
            lo[i].x = __uint_as_float(q.x << 16); lo[i].y = __uint_as_float(q.x & 0xFFFF0000u); lo[i].z = __uint_as_float(q.y << 16); lo[i].w = __uint_as_float(q.y & 0xFFFF0000u);
            hi[i].x = __uint_as_float(q.z << 16); hi[i].y = __uint_as_float(q.z & 0xFFFF0000u); hi[i].z = __uint_as_float(q.w << 16); hi[i].w = __uint_as_float(q.w & 0xFFFF0000u);
            if (i < 5) { *(float4*)(dst + i * 64) = lo[i]; *(float4*)(dst + i * 64 + 4) = hi[i]; }
            }
        float be = lo[3].x * lo[2].x + lo[3].y * lo[2].y + lo[3].z * lo[2].z + lo[3].w * lo[2].w + hi[3].x * hi[2].x + hi[3].y * hi[2].y + hi[3].z * hi[2].z + hi[3].w * hi[2].w;
        be += __shfl_xor(be, 1); be += __shfl_xor(be, 2); be += __shfl_xor(be, 4);
        if ((part >> 1) == (vbase >> 4)) { float* dv = buf + (nb & 1) * (32 * SST) + lj * SST + 320 + (part & 1) * 16;
            *(float4*)dv = make_float4(lo[5].x, be, lo[5].y, be); *(float4*)(dv + 4) = make_float4(lo[5].z, be, lo[5].w, be); *(float4*)(dv + 8) = make_float4(hi[5].x, be, hi[5].y, be); *(float4*)(dv + 12) = make_float4(hi[5].z, be, hi[5].w, be); }
    };
    auto flush = [&](int nb) {
        const float* src = ybuf + (nb & 1) * 4096;
#pragma unroll
        for (int i = 0; i < 2; ++i) { const int idx = lt + 256 * i, j = idx >> 4, vl = idx & 15; const float4 q = *(const float4*)(src + idx * 8), q2 = *(const float4*)(src + idx * 8 + 4);
            Z[(size_t)rw_row(b, dir, nb * 32 + j) * ZLD + Z_RW + dir * 256 + h * 64 + vbase + vl] = f2bf(((q.x + q.y) + (q.z + q.w)) + ((q2.x + q2.y) + (q2.z + q2.w))); }
    };
    if (loader) { gload(0); lwrite(0); gload(1); }
    __syncthreads();
    const int wv = tid >> 6, lane = tid & 63, vr = lane >> 4, kl = lane & 15, vloc = wv * 4 + vr;
    f32x2_ s01 = {0.f, 0.f}, s23 = {0.f, 0.f}; float sa = 0.f;
    for (int nb = 0; nb < NBATCH; ++nb) {
        if (loader) { if (nb + 1 < NBATCH) lwrite(nb + 1); if (nb + 2 < NBATCH) gload(nb + 2); if (nb >= 1) flush(nb - 1); }
        else {
            const float* base_ = buf + (nb & 1) * (32 * SST);
            unsigned yoff_ = (unsigned)((2 * 32 * SST + (nb & 1) * 4096 + vloc * 8 + (kl & 7)) * 4); asm volatile("" : "+v"(yoff_));
            float* yd = (float*)(lds + yoff_);
#define SC_LD(J, W, KD, AN, B, R, V, BE) { const float* sj_ = base_ + (J) * SST; W = *(const float4*)(sj_ + kl * 4); KD = *(const float4*)(sj_ + 64 + kl * 4); AN = *(const float4*)(sj_ + 128 + kl * 4); \
                B = *(const float4*)(sj_ + 192 + kl * 4); R = *(const float4*)(sj_ + 256 + kl * 4); { const float2 vb_ = *(const float2*)(sj_ + 320 + 2 * vloc); V = vb_.x; BE = vb_.y; } }
            float4 w, kd, an, bb, r, w1, kd1, an1, bb1, r1; float v, v1, be, be1;
            SC_LD(0, w, kd, an, bb, r, v, be); SC_LD(1, w1, kd1, an1, bb1, r1, v1, be1);
#pragma unroll 16
            for (int j = 0; j < 32; ++j) {
                const int jn = j < 30 ? j + 2 : 31;
                float4 wn, kdn, ann, bn, rn; float vn, ben; SC_LD(jn, wn, kdn, ann, bn, rn, vn, ben);
                const f32x2_ vv = {v, v};
                const f32x2_ u01 = s01 - s01 * (f32x2_){w.x, w.y} + vv * (f32x2_){kd.x, kd.y}, u23 = s23 - s23 * (f32x2_){w.z, w.w} + vv * (f32x2_){kd.z, kd.w};
                f32x2_ t = u01 * (f32x2_){an.x, an.y}; t = u23 * (f32x2_){an.z, an.w} + t;
                const float rsum = row16_allsum(t.x + t.y);
                const f32x2_ sav = {sa, sa};
                s01 = (f32x2_){bb.x, bb.y} * sav + u01; s23 = (f32x2_){bb.z, bb.w} * sav + u23;
                f32x2_ yv = s01 * (f32x2_){r.x, r.y}; yv = s23 * (f32x2_){r.z, r.w} + yv;
                float y = yv.x + yv.y; y += dpp_<0x128>(y);
                yd[j * 128] = y;
                sa = rsum + sa * be;
                w = w1; kd = kd1; an = an1; bb = bb1; r = r1; v = v1; be = be1; w1 = wn; kd1 = kdn; an1 = ann; bb1 = bn; r1 = rn; v1 = vn; be1 = ben; }
#undef SC_LD
        }
        __syncthreads();
    }
    if (loader) flush(NBATCH - 1);
    __syncthreads();
}
struct FinIn { uint2 yf, yb, vq, gq; float bonus; };
DI FinIn rwkv_finish_load(const Params& p, int row, int lane) {
    const bf16_t* Z = (const bf16_t*)(p.ws + WS_Z) + (size_t)row * ZLD; const bf16_t* op = (const bf16_t*)(p.ws + WS_RWOP) + (size_t)row * RWLD; const int c = lane * 4;
    FinIn f; f.bonus = ((const float*)(p.ws + WS_BON))[(size_t)row * 4 + (lane >> 4)];
    f.yf = *(const uint2*)(Z + Z_RW + c); f.yb = *(const uint2*)(Z + Z_RW + 256 + c); f.vq = *(const uint2*)(op + 256 + c); f.gq = *(const uint2*)(op + 2304 + c); return f;
}
DI void rwkv_finish_row(const Params& p, int layer, int row, int lane, const FinIn& f) {
    bf16_t* Y = (bf16_t*)(p.ws + WS_H); const int c = lane * 4; const uint2 yf = f.yf, yb = f.yb, vq = f.vq, gq = f.gq; const float bonus = f.bonus;
    float y[4] = {__uint_as_float(yf.x << 16) + __uint_as_float(yb.x << 16), __uint_as_float(yf.x & 0xFFFF0000u) + __uint_as_float(yb.x & 0xFFFF0000u),
                  __uint_as_float(yf.y << 16) + __uint_as_float(yb.y << 16), __uint_as_float(yf.y & 0xFFFF0000u) + __uint_as_float(yb.y & 0xFFFF0000u)};
    const float v[4] = {__uint_as_float(vq.x << 16), __uint_as_float(vq.x & 0xFFFF0000u), __uint_as_float(vq.y << 16), __uint_as_float(vq.y & 0xFFFF0000u)};
    const float g[4] = {__uint_as_float(gq.x << 16), __uint_as_float(gq.x & 0xFFFF0000u), __uint_as_float(gq.y << 16), __uint_as_float(gq.y & 0xFFFF0000u)};
    const float mean = row16_allsum((y[0] + y[1]) + (y[2] + y[3])) * (1.f / 64.f);
    float d[4], q = 0.f;
#pragma unroll
    for (int i = 0; i < 4; ++i) { d[i] = y[i] - mean; q += d[i] * d[i]; }
    const float rstd = rsqrtf(row16_allsum(q) * (1.f / 64.f) + 64e-5f);
    const float4 lg = *(const float4*)(PIN(I_RWLNG) + layer * 256 + c), lb = *(const float4*)(PIN(I_RWLNB) + layer * 256 + c);
    const float lgv[4] = {lg.x, lg.y, lg.z, lg.w}, lbv[4] = {lb.x, lb.y, lb.z, lb.w}; float o[4];
#pragma unroll
    for (int i = 0; i < 4; ++i) o[i] = (d[i] * rstd * lgv[i] + lbv[i] + bonus * v[i]) * g[i];
    uint2 w; w.x = pk2(o[0], o[1]); w.y = pk2(o[2], o[3]); *(uint2*)(Y + (size_t)row * D + 256 + c) = w;
}

DI void s5_stage_u(const Params& p, int row0, int g, float* ubuf, int lane) {
    const bf16_t* Z = (const bf16_t*)(p.ws + WS_Z);
    const u32x4* src = (const u32x4*)(Z + (size_t)(row0 + lane) * ZLD + g * 16);
    const u32x4 a = src[0], b = src[1]; float* d = ubuf + lane * 16;
    const unsigned w[8] = {a.x, a.y, a.z, a.w, b.x, b.y, b.z, b.w};
#pragma unroll
    for (int i = 0; i < 8; ++i) { d[2 * i] = __uint_as_float(w[i] << 16); d[2 * i + 1] = __uint_as_float(w[i] & 0xFFFF0000u); }
    WAVE_LDS_SYNC();
}
DI void s5_step(float& hr, float& hi, const float ar, const float ai, const float (&Br)[16], const float (&Bi)[16], const float* u) {
    const float4 u0 = *(const float4*)u, u1 = *(const float4*)(u + 4), u2 = *(const float4*)(u + 8), u3 = *(const float4*)(u + 12);
    const float uu[16] = {u0.x, u0.y, u0.z, u0.w, u1.x, u1.y, u1.z, u1.w, u2.x, u2.y, u2.z, u2.w, u3.x, u3.y, u3.z, u3.w};
    float br = 0.f, bi = 0.f;
#pragma unroll
    for (int q = 0; q < 16; ++q) { br += Br[q] * uu[q]; bi += Bi[q] * uu[q]; }
    const float nr = ar * hr - ai * hi + br, ni = ar * hi + ai * hr + bi; hr = nr; hi = ni;
}
DI void s5_stage1_item(const Params& p, int layer, int item, unsigned char* lds) {
    const int tid = otid(), wave = tid >> 6, lane = tid & 63;
    const int b = item / 1040, rem = item % 1040, ci = rem >> 2, idx = (rem & 3) * 8 + wave, g = idx >> 1, dir = idx & 1;
    float* ubuf = (float*)(lds + wave * 4096);
    const int row0 = chunk_row0(b, ci);
    s5_stage_u(p, row0, g, ubuf, lane);
    const size_t e = ((size_t)(layer * 2 + dir) * 16 + g) * 64 + lane;
    const float* abar = (const float*)(p.ws + WS_S5A); const float* bbar = (const float*)(p.ws + WS_S5B);
    const float ar = abar[e * 2], ai = abar[e * 2 + 1]; float Br[16], Bi[16];
#pragma unroll
    for (int q = 0; q < 8; ++q) { const float4 t = *(const float4*)(bbar + e * 32 + q * 4); Br[2 * q] = t.x; Bi[2 * q] = t.y; Br[2 * q + 1] = t.z; Bi[2 * q + 1] = t.w; }
    float hr = 0.f, hi = 0.f;
    for (int i = 0; i < 64; ++i) { const int t = dir ? 63 - i : i; s5_step(hr, hi, ar, ai, Br, Bi, ubuf + t * 16); }
    float2* E = (float2*)(p.ws + WS_S5E);
    E[((((size_t)b * 2 + dir) * 16 + g) * NCH + ci) * 64 + lane] = make_float2(hr, hi);
    __syncthreads();
}
DI bf16x8 ldfrag_l(const bf16_t* base, int stride, int r0, int k0, int lane) { return *(const bf16x8*)(base + (size_t)(r0 + (lane & 15)) * stride + k0 + (lane >> 4) * 8); }
DI void s5_stage3_item(const Params& p, int layer, int item, unsigned char* lds) {
    const int tid = otid(), wave = tid >> 6, lane = tid & 63, b = item / NCH, ci = item % NCH, row0 = chunk_row0(b, ci);
    float* ubuf = (float*)(lds + wave * 18432);
    float* yb = ubuf + 1024;
    bf16_t* Hl = (bf16_t*)(yb + 1024);
    constexpr int HST = 136;
    const float* abar = (const float*)(p.ws + WS_S5A); const float* bbar = (const float*)(p.ws + WS_S5B); const float2* E = (const float2*)(p.ws + WS_S5E);
    bf16_t* Y = (bf16_t*)(p.ws + WS_H);
    const int quad = lane >> 4, col = lane & 15;
#pragma unroll 1
    for (int gi = 0; gi < 2; ++gi) { const int g = wave * 2 + gi;
        s5_stage_u(p, row0, g, ubuf, lane);
        const float dsk = PIN(I_S5D)[layer * 256 + g * 16 + col];
#pragma unroll 1
        for (int dir = 0; dir < 2; ++dir) {
            const size_t gd = (size_t)(layer * 2 + dir) * 16 + g, e = gd * 64 + lane;
            const float ar = abar[e * 2], ai = abar[e * 2 + 1]; float Br[16], Bi[16];
#pragma unroll
            for (int q = 0; q < 8; ++q) { const float4 t = *(const float4*)(bbar + e * 32 + q * 4); Br[2 * q] = t.x; Bi[2 * q] = t.y; Br[2 * q + 1] = t.z; Bi[2 * q + 1] = t.w; }
            bf16x8 Cf[4]; { const bf16_t* cm = (const bf16_t*)(p.ws + WS_CM) + (gd * 16 + col) * 128;
#pragma unroll
              for (int kk = 0; kk < 4; ++kk) Cf[kk] = *(const bf16x8*)(cm + kk * 32 + quad * 8); }
            const float2 h0_ = E[((((size_t)b * 2 + dir) * 16 + g) * NCH + ci) * 64 + lane]; float hr = h0_.x, hi = h0_.y;
#pragma unroll 1
            for (int q = 0; q < 4; ++q) { const int ti = dir ? 3 - q : q;
#pragma unroll 1
                for (int i = 0; i < 16; ++i) { const int tt = dir ? 15 - i : i; s5_step(hr, hi, ar, ai, Br, Bi, ubuf + (ti * 16 + tt) * 16); *(unsigned*)(Hl + tt * HST + 2 * lane) = pk2(hr, hi); }
                WAVE_LDS_SYNC();
                f32x4 acc = {0.f, 0.f, 0.f, 0.f};
#pragma unroll
                for (int kk = 0; kk < 4; ++kk) acc = __builtin_amdgcn_mfma_f32_16x16x32_bf16(ldfrag_l(Hl, HST, 0, kk * 32, lane), Cf[kk], acc, 0, 0, 0);
#pragma unroll
                for (int j = 0; j < 4; ++j) { const int t = ti * 16 + quad * 4 + j;
                    if (dir == 0) yb[t * 16 + col] = acc[j];
                    else { const float y = yb[t * 16 + col] + acc[j] + dsk * ubuf[t * 16 + col]; Y[(size_t)(row0 + t) * D + g * 16 + col] = f2bf(gelu_tanh_(y)); } }
                WAVE_LDS_SYNC(); }
        }
        WAVE_LDS_SYNC();
    }
    __syncthreads();
}
DI bf16x8 ldfrag(const bf16_t* base, int stride, int r0, int k0, int lane) { return *(const bf16x8*)(base + (size_t)(r0 + (lane & 15)) * stride + k0 + (lane >> 4) * 8); }
DI void s5_glu_item(const Params& p, int layer, int item, unsigned char* lds) {
    const int tid = otid(), wave = tid >> 6, lane = tid & 63, r0 = item * 64 + (wave >> 1) * 16, c0 = (wave & 1) * 128;
    bf16_t* Y = (bf16_t*)(p.ws + WS_H); const bf16_t* WT = (const bf16_t*)(p.ws + WS_WTGLU);
    f32x4 acc[8];
#pragma unroll
    for (int t = 0; t < 8; ++t) acc[t] = (f32x4){0.f, 0.f, 0.f, 0.f};
#pragma unroll 1
    for (int k0 = 0; k0 < 256; k0 += 32) { const bf16x8 a = ldfrag(Y, D, r0, k0, lane);
#pragma unroll
        for (int t = 0; t < 8; ++t) { const bf16x8 bfr = ldfrag(WT, 256, c0 + t * 16, k0, lane); acc[t] = __builtin_amdgcn_mfma_f32_16x16x32_bf16(a, bfr, acc[t], 0, 0, 0); } }
    __syncthreads();
    const float* gb = PIN(I_S5GB) + layer * 256;
#pragma unroll
    for (int t = 0; t < 8; ++t) { const int col = c0 + t * 16 + (lane & 15);
#pragma unroll
        for (int j = 0; j < 4; ++j) { bf16_t* py = Y + (size_t)(r0 + (lane >> 4) * 4 + j) * D + col; const float y = bf2f(*py); *py = f2bf(y * sigmoid_(acc[t][j] + gb[col])); } }
    __syncthreads();
}

constexpr int CST = 72;
DI float flogsig_(float x) { return -(fmaxf(-x, 0.f) + __logf(1.f + __expf(-fabsf(x)))); }
DI void gla_cum(const Params& p, int layer, int h, int row0, float* cum, int tid) {
    const int wave = __builtin_amdgcn_readfirstlane(tid >> 6), lane = tid & 63; const bf16_t* Z = (const bf16_t*)(p.ws + WS_Z);
    const u32x4* ap = (const u32x4*)(Z + (size_t)(row0 + lane) * ZLD + Z_GLA + 768); const u32x4 q0 = ap[0], q1 = ap[1];
    const unsigned w[8] = {q0.x, q0.y, q0.z, q0.w, q1.x, q1.y, q1.z, q1.w}; float al[16];
#pragma unroll
    for (int i = 0; i < 8; ++i) { al[2 * i] = __uint_as_float(w[i] << 16); al[2 * i + 1] = __uint_as_float(w[i] & 0xFFFF0000u); }
#pragma unroll
    for (int i = 0; i < 8; ++i) { const int c = wave * 8 + i, d = c >> 5, k = c & 31;
        const float* au = PIN(I_GLAAUP) + (size_t)(layer * 2 + d) * 16 * 128 + h * 32 + k; float x = PIN(I_GLAAB)[(layer * 2 + d) * 128 + h * 32 + k];
#pragma unroll
        for (int j = 0; j < 16; ++j) x += al[j] * au[j * 128];
        x = flogsig_(x) * (1.f / 16.f);
        if (d == 0) {
#pragma unroll
            for (int o = 1; o < 64; o <<= 1) { const float t = __shfl_up(x, o); if (lane >= o) x += t; } }
        else {
#pragma unroll
            for (int o = 1; o < 64; o <<= 1) { const float t = __shfl_down(x, o); if (lane + o < 64) x += t; } }
        cum[(d * 64 + lane) * 32 + k] = x; }
}
struct QK4 { float q1[4], q2[4], k1[4], k2[4]; int d1, d2; };
template <int DK, bool RET> DI void chunk_loadqk(const Params& p, int h, int row0, int ci, int s, int pp, QK4& o) {
    const bf16_t* Z = (const bf16_t*)(p.ws + WS_Z); const bf16_t* zr = Z + (size_t)(row0 + s) * ZLD;
    if (RET) { const int hi = pp >> 2, off = (pp & 3) * 4; o.d1 = hi * 32 + off; o.d2 = o.d1 + 16;
        const int qcol = Z_RET + h * 64, kcol = Z_RET + 256 + h * 64;
        const uint2 a = *(const uint2*)(zr + qcol + o.d1), b = *(const uint2*)(zr + qcol + o.d2), c = *(const uint2*)(zr + kcol + o.d1), d = *(const uint2*)(zr + kcol + o.d2);
        o.q1[0] = __uint_as_float(a.x << 16); o.q1[1] = __uint_as_float(a.x & 0xFFFF0000u); o.q1[2] = __uint_as_float(a.y << 16); o.q1[3] = __uint_as_float(a.y & 0xFFFF0000u);
        o.q2[0] = __uint_as_float(b.x << 16); o.q2[1] = __uint_as_float(b.x & 0xFFFF0000u); o.q2[2] = __uint_as_float(b.y << 16); o.q2[3] = __uint_as_float(b.y & 0xFFFF0000u);
        o.k1[0] = __uint_as_float(c.x << 16); o.k1[1] = __uint_as_float(c.x & 0xFFFF0000u); o.k1[2] = __uint_as_float(c.y << 16); o.k1[3] = __uint_as_float(c.y & 0xFFFF0000u);
        o.k2[0] = __uint_as_float(d.x << 16); o.k2[1] = __uint_as_float(d.x & 0xFFFF0000u); o.k2[2] = __uint_as_float(d.y << 16); o.k2[3] = __uint_as_float(d.y & 0xFFFF0000u);
#pragma unroll
        for (int e = 0; e < 4; ++e) { o.k1[e] *= 0.125f; o.k2[e] *= 0.125f; }
        if (ci >= 4) { const float2* rope = (const float2*)(p.ws + WS_ROPE) + (hi == 0 ? (ci - 4) * 16 : 4096 + s * 16) + off;
#pragma unroll
            for (int e = 0; e < 4; ++e) { const float2 cs = rope[e]; float t1 = o.q1[e] * cs.x - o.q2[e] * cs.y, t2 = o.q1[e] * cs.y + o.q2[e] * cs.x; o.q1[e] = t1; o.q2[e] = t2;
                t1 = o.k1[e] * cs.x - o.k2[e] * cs.y; t2 = o.k1[e] * cs.y + o.k2[e] * cs.x; o.k1[e] = t1; o.k2[e] = t2; } }
    } else { o.d1 = pp * 4; o.d2 = 0; const int qcol = Z_GLA + h * 32, kcol = Z_GLA + 128 + h * 32;
        const uint2 a = *(const uint2*)(zr + qcol + o.d1), c = *(const uint2*)(zr + kcol + o.d1);
        o.q1[0] = __uint_as_float(a.x << 16); o.q1[1] = __uint_as_float(a.x & 0xFFFF0000u); o.q1[2] = __uint_as_float(a.y << 16); o.q1[3] = __uint_as_float(a.y & 0xFFFF0000u);
        o.k1[0] = __uint_as_float(c.x << 16) * 0.17677669529663687f; o.k1[1] = __uint_as_float(c.x & 0xFFFF0000u) * 0.17677669529663687f; o.k1[2] = __uint_as_float(c.y << 16) * 0.17677669529663687f; o.k1[3] = __uint_as_float(c.y & 0xFFFF0000u) * 0.17677669529663687f;
#pragma unroll
        for (int e = 0; e < 4; ++e) { o.q2[e] = 0.f; o.k2[e] = 0.f; } }
}
template <bool RET> DI void chunk_loadv(const Params& p, int h, int row0, int s, int pp, bf16_t* vT) {
    const bf16_t* Z = (const bf16_t*)(p.ws + WS_Z); const int vcol = RET ? Z_RET + 512 + h * 64 : Z_GLA + 256 + h * 64;
    const u32x4 q = *(const u32x4*)(Z + (size_t)(row0 + s) * ZLD + vcol + pp * 8); const unsigned w[4] = {q.x, q.y, q.z, q.w};
#pragma unroll
    for (int i = 0; i < 4; ++i) { vT[(pp * 8 + 2 * i) * CST + s] = (bf16_t)(w[i] & 0xFFFFu); vT[(pp * 8 + 2 * i + 1) * CST + s] = (bf16_t)(w[i] >> 16); }
}
template <int DK, bool RET> DI void chunk_stageA(const Params& p, int layer, int item, unsigned char* lds) {
    const int tid = otid(), wave = tid >> 6, lane = tid & 63, b = item / (4 * NCH), h = (item / NCH) & 3, ci = item % NCH, row0 = chunk_row0(b, ci);
    float* cum = (float*)lds; bf16_t* kT0 = (bf16_t*)(lds + 32768); bf16_t* kT1 = kT0 + 64 * CST; bf16_t* vT = (bf16_t*)(lds + 32768 + 4 * 9216);
    const int s = tid >> 3, pp = tid & 7;
    float la0 = 0.f, la1 = 0.f;
    if (RET) { la0 = flogsig_(PIN(I_RETDEC)[(layer * 2 + 0) * 4 + h]); la1 = flogsig_(PIN(I_RETDEC)[(layer * 2 + 1) * 4 + h]); }
    else { gla_cum(p, layer, h, row0, cum, tid); __syncthreads(); }
    QK4 x; chunk_loadqk<DK, RET>(p, h, row0, ci, s, pp, x);
    chunk_loadv<RET>(p, h, row0, s, pp, vT);
    if (RET) { const float e0 = __expf(la0 * (float)(63 - s)), e1 = __expf(la1 * (float)s);
#pragma unroll
        for (int e = 0; e < 4; ++e) { kT0[(x.d1 + e) * CST + s] = f2bf(x.k1[e] * e0); kT0[(x.d2 + e) * CST + s] = f2bf(x.k2[e] * e0); kT1[(x.d1 + e) * CST + s] = f2bf(x.k1[e] * e1); kT1[(x.d2 + e) * CST + s] = f2bf(x.k2[e] * e1); }
    } else {
#pragma unroll
        for (int e = 0; e < 4; ++e) { const int d = x.d1 + e;
            kT0[d * CST + s] = f2bf(x.k1[e] * __expf(cum[63 * 32 + d] - cum[s * 32 + d])); kT1[d * CST + s] = f2bf(x.k1[e] * __expf(cum[64 * 32 + d] - cum[(64 + s) * 32 + d])); } }
    float* DEC = (float*)(p.ws + (RET ? WS_DECR : WS_DECG));
    if (tid < 2 * DK) { const int d = tid / DK, k = tid % DK; const int chain = (b * 4 + h) * 2 + d;
        DEC[((size_t)chain * NCH + ci) * DK + k] = RET ? __expf(64.f * (d ? la1 : la0)) : __expf(d == 0 ? cum[63 * 32 + k] : cum[64 * 32 + k]); }
    __syncthreads();
    bf16_t* CS = (bf16_t*)(p.ws + (RET ? WS_CSR : WS_CSG));
    constexpr int KT = DK / 16;
    for (int tt = wave; tt < 2 * 4 * KT; tt += 8) { const int d = tt / (4 * KT), vt = (tt / KT) & 3, kt = tt % KT; const bf16_t* kT = d ? kT1 : kT0;
        f32x4 acc = {0.f, 0.f, 0.f, 0.f};
#pragma unroll
        for (int s0 = 0; s0 < 64; s0 += 32) acc = __builtin_amdgcn_mfma_f32_16x16x32_bf16(ldfrag(vT, CST, vt * 16, s0, lane), ldfrag(kT, CST, kt * 16, s0, lane), acc, 0, 0, 0);
        const int chain = (b * 4 + h) * 2 + d; bf16_t* dst = CS + ((size_t)chain * NCH + ci) * 64 * DK;
#pragma unroll
        for (int j = 0; j < 4; ++j) dst[(vt * 16 + (lane >> 4) * 4 + j) * DK + kt * 16 + (lane & 15)] = f2bf(acc[j]); }
    __syncthreads();
}
template <int DK, bool RET> DI void chunk_stageB_task(const Params& p, int task) {
    constexpr int GPC = 64 * DK / 8; const int chain = task / GPC, eg = task % GPC, d = chain & 1, k0 = (eg * 8) % DK;
    bf16_t* CS = (bf16_t*)(p.ws + (RET ? WS_CSR : WS_CSG)); const float* DEC = (const float*)(p.ws + (RET ? WS_DECR : WS_DECG));
    float S[8] = {0, 0, 0, 0, 0, 0, 0, 0};
    for (int pos0 = 0; pos0 < NCH; pos0 += 4) {
        u32x4 kv[4]; float4 d0[4], d1[4];
#pragma unroll
        for (int i = 0; i < 4; ++i) { const int ci = chunk_at(d, pos0 + i); kv[i] = *(const u32x4*)(CS + ((size_t)chain * NCH + ci) * 64 * DK + eg * 8);
            const float* dc = DEC + ((size_t)chain * NCH + ci) * DK + k0; d0[i] = *(const float4*)dc; d1[i] = *(const float4*)(dc + 4); }
#pragma unroll
        for (int i = 0; i < 4; ++i) { const int ci = chunk_at(d, pos0 + i); u32x4* ptr = (u32x4*)(CS + ((size_t)chain * NCH + ci) * 64 * DK + eg * 8);
            u32x4 o; o.x = pk2(S[0], S[1]); o.y = pk2(S[2], S[3]); o.z = pk2(S[4], S[5]); o.w = pk2(S[6], S[7]); *ptr = o;
            const unsigned w[4] = {kv[i].x, kv[i].y, kv[i].z, kv[i].w}; const float dd[8] = {d0[i].x, d0[i].y, d0[i].z, d0[i].w, d1[i].x, d1[i].y, d1[i].z, d1[i].w};
#pragma unroll
            for (int j = 0; j < 4; ++j) { S[2 * j] = dd[2 * j] * S[2 * j] + __uint_as_float(w[j] << 16); S[2 * j + 1] = dd[2 * j + 1] * S[2 * j + 1] + __uint_as_float(w[j] & 0xFFFF0000u); } } }
}
template <int DK, bool RET> DI void chunk_stageC(const Params& p, int layer, int item, unsigned char* lds) {
    const int tid = otid(), wave = tid >> 6, lane = tid & 63, b = item / (4 * NCH), h = (item / NCH) & 3, ci = item % NCH, row0 = chunk_row0(b, ci);
    float* cum = (float*)lds; bf16_t* qf = (bf16_t*)(lds + 32768); bf16_t* qb = qf + 64 * CST; bf16_t* kf = qb + 64 * CST; bf16_t* kb = kf + 64 * CST;
    bf16_t* vT = kb + 64 * CST; bf16_t* P = vT + 64 * CST; float* ob = (float*)(lds + 32768 + 6 * 9216);
    const bf16_t* Z = (const bf16_t*)(p.ws + WS_Z);
    { const int s = tid >> 3, pp = tid & 7;
      if (!RET) { gla_cum(p, layer, h, row0, cum, tid); __syncthreads(); }
      QK4 x; chunk_loadqk<DK, RET>(p, h, row0, ci, s, pp, x);
      chunk_loadv<RET>(p, h, row0, s, pp, vT);
      if (RET) { const float la0 = flogsig_(PIN(I_RETDEC)[(layer * 2 + 0) * 4 + h]), la1 = flogsig_(PIN(I_RETDEC)[(layer * 2 + 1) * 4 + h]);
          const float cf = la0 * (float)(s + 1), cb = la1 * (float)(64 - s); const float ef = __expf(cf), eb = __expf(cb), nf = __expf(-cf), nb_ = __expf(-cb);
          uint2 w;
          w.x = pk2(x.q1[0] * ef, x.q1[1] * ef); w.y = pk2(x.q1[2] * ef, x.q1[3] * ef); *(uint2*)(qf + s * CST + x.d1) = w; w.x = pk2(x.q2[0] * ef, x.q2[1] * ef); w.y = pk2(x.q2[2] * ef, x.q2[3] * ef); *(uint2*)(qf + s * CST + x.d2) = w;
          w.x = pk2(x.q1[0] * eb, x.q1[1] * eb); w.y = pk2(x.q1[2] * eb, x.q1[3] * eb); *(uint2*)(qb + s * CST + x.d1) = w; w.x = pk2(x.q2[0] * eb, x.q2[1] * eb); w.y = pk2(x.q2[2] * eb, x.q2[3] * eb); *(uint2*)(qb + s * CST + x.d2) = w;
          w.x = pk2(x.k1[0] * nf, x.k1[1] * nf); w.y = pk2(x.k1[2] * nf, x.k1[3] * nf); *(uint2*)(kf + s * CST + x.d1) = w; w.x = pk2(x.k2[0] * nf, x.k2[1] * nf); w.y = pk2(x.k2[2] * nf, x.k2[3] * nf); *(uint2*)(kf + s * CST + x.d2) = w;
          w.x = pk2(x.k1[0] * nb_, x.k1[1] * nb_); w.y = pk2(x.k1[2] * nb_, x.k1[3] * nb_); *(uint2*)(kb + s * CST + x.d1) = w; w.x = pk2(x.k2[0] * nb_, x.k2[1] * nb_); w.y = pk2(x.k2[2] * nb_, x.k2[3] * nb_); *(uint2*)(kb + s * CST + x.d2) = w;
      } else { float a[4], bq[4], c[4], d[4];
#pragma unroll
          for (int e = 0; e < 4; ++e) { const float cf = cum[s * 32 + x.d1 + e], cb = cum[(64 + s) * 32 + x.d1 + e]; a[e] = x.q1[e] * __expf(cf); bq[e] = x.q1[e] * __expf(cb); c[e] = x.k1[e] * __expf(-cf); d[e] = x.k1[e] * __expf(-cb); }
          uint2 w; w.x = pk2(a[0], a[1]); w.y = pk2(a[2], a[3]); *(uint2*)(qf + s * CST + x.d1) = w; w.x = pk2(bq[0], bq[1]); w.y = pk2(bq[2], bq[3]); *(uint2*)(qb + s * CST + x.d1) = w;
          w.x = pk2(c[0], c[1]); w.y = pk2(c[2], c[3]); *(uint2*)(kf + s * CST + x.d1) = w; w.x = pk2(d[0], d[1]); w.y = pk2(d[2], d[3]); *(uint2*)(kb + s * CST + x.d1) = w; } }
    __syncthreads();
#pragma unroll
    for (int i = 0; i < 2; ++i) { const int tt = wave + 8 * i, ti = tt >> 2, si = tt & 3;
        f32x4 aF = {0.f, 0.f, 0.f, 0.f}, aB = {0.f, 0.f, 0.f, 0.f};
        if (si <= ti) {
#pragma unroll
            for (int k0 = 0; k0 < DK; k0 += 32) aF = __builtin_amdgcn_mfma_f32_16x16x32_bf16(ldfrag(qf, CST, ti * 16, k0, lane), ldfrag(kf, CST, si * 16, k0, lane), aF, 0, 0, 0); }
        if (si >= ti) {
#pragma unroll
            for (int k0 = 0; k0 < DK; k0 += 32) aB = __builtin_amdgcn_mfma_f32_16x16x32_bf16(ldfrag(qb, CST, ti * 16, k0, lane), ldfrag(kb, CST, si * 16, k0, lane), aB, 0, 0, 0); }
#pragma unroll
        for (int j = 0; j < 4; ++j) { const int t = ti * 16 + (lane >> 4) * 4 + j, s = si * 16 + (lane & 15);
            const float val = (s < t ? aF[j] : 0.f) + (s > t ? aB[j] : 0.f) + (s == t ? aF[j] + aB[j] : 0.f); P[t * CST + s] = f2bf(val); } }
    __syncthreads();
    const bf16_t* CS = (const bf16_t*)(p.ws + (RET ? WS_CSR : WS_CSG));
    const bf16_t* Sf = CS + ((size_t)((b * 4 + h) * 2 + 0) * NCH + ci) * 64 * DK; const bf16_t* Sb = CS + ((size_t)((b * 4 + h) * 2 + 1) * NCH + ci) * 64 * DK;
#pragma unroll
    for (int i = 0; i < 2; ++i) { const int tt = wave + 8 * i, ti = tt >> 2, vi = tt & 3;
        f32x4 acc = {0.f, 0.f, 0.f, 0.f};
#pragma unroll
        for (int s0 = 0; s0 < 64; s0 += 32) acc = __builtin_amdgcn_mfma_f32_16x16x32_bf16(ldfrag(P, CST, ti * 16, s0, lane), ldfrag(vT, CST, vi * 16, s0, lane), acc, 0, 0, 0);
#pragma unroll
        for (int k0 = 0; k0 < DK; k0 += 32) { acc = __builtin_amdgcn_mfma_f32_16x16x32_bf16(ldfrag(qf, CST, ti * 16, k0, lane), ldfrag(Sf, DK, vi * 16, k0, lane), acc, 0, 0, 0);
            acc = __builtin_amdgcn_mfma_f32_16x16x32_bf16(ldfrag(qb, CST, ti * 16, k0, lane), ldfrag(Sb, DK, vi * 16, k0, lane), acc, 0, 0, 0); }
#pragma unroll
        for (int j = 0; j < 4; ++j) ob[(ti * 16 + (lane >> 4) * 4 + j) * 65 + vi * 16 + (lane & 15)] = acc[j]; }
    __syncthreads();
    { const int t = tid >> 3, v0 = (tid & 7) * 8; float o[8], ss = 0.f;
#pragma unroll
      for (int i = 0; i < 8; ++i) { o[i] = ob[t * 65 + v0 + i]; ss += o[i] * o[i]; }
      ss += __shfl_xor(ss, 1); ss += __shfl_xor(ss, 2); ss += __shfl_xor(ss, 4);
      const float rstd = rsqrtf(ss * (1.f / 64.f) + 1e-6f);
      const int gcol = RET ? Z_RET + 768 + h * 64 : Z_GLA + 512 + h * 64, ycol = RET ? 512 : 768;
      const float* lng = PIN(RET ? I_RETLNG : I_GLALNG) + layer * 256 + h * 64 + v0;
      const bf16_t* gz = Z + (size_t)(row0 + t) * ZLD + gcol + v0; float r[8];
#pragma unroll
      for (int i = 0; i < 8; ++i) r[i] = o[i] * rstd * lng[i] * silu_(bf2f(gz[i]));
      u32x4 w; w.x = pk2(r[0], r[1]); w.y = pk2(r[2], r[3]); w.z = pk2(r[4], r[5]); w.w = pk2(r[6], r[7]);
      *(u32x4*)((bf16_t*)(p.ws + WS_H) + (size_t)(row0 + t) * D + ycol + h * 64 + v0) = w; }
    __syncthreads();
}

DI void phase_m1(const Params& p, int layer, unsigned char* lds) {
    for (int it = blockIdx.x; it < NROW / 16; it += gridDim.x) rwkv_prep_item(p, layer, it, lds);
}
DI void s5_prefix_task(const Params& p, int layer, int task) {
    const int n = task & 63, g = (task >> 6) & 15, dir = (task >> 10) & 1, b = task >> 11;
    const size_t e = ((size_t)(layer * 2 + dir) * 16 + g) * 64 + n; const float* abar = (const float*)(p.ws + WS_S5A);
    float pr = abar[e * 2], pi = abar[e * 2 + 1];
#pragma unroll
    for (int q = 0; q < 6; ++q) { const float nr = pr * pr - pi * pi, ni = 2.f * pr * pi; pr = nr; pi = ni; }
    float2* Eb = (float2*)(p.ws + WS_S5E) + (((size_t)b * 2 + dir) * 16 + g) * NCH * 64 + n;
    float hr = 0.f, hi = 0.f;
    for (int pos0 = 0; pos0 < NCH; pos0 += 4) { float2 ev[4];
#pragma unroll
        for (int i = 0; i < 4; ++i) ev[i] = Eb[(size_t)chunk_at(dir, pos0 + i) * 64];
#pragma unroll
        for (int i = 0; i < 4; ++i) { Eb[(size_t)chunk_at(dir, pos0 + i) * 64] = make_float2(hr, hi);
            const float nr = pr * hr - pi * hi + ev[i].x, ni = pr * hi + pi * hr + ev[i].y; hr = nr; hi = ni; } }
}
DI void convert_late(const Params& p, int layer, unsigned char* lds, int gw, int NGW) {
    const int tid = otid(), wave = tid >> 6, lane = tid & 63; float* scr = (float*)(lds + wave * 8704);
    constexpr int I_OUT = 16 * 32, I_1 = 16 * 128, I_2 = 64 * 32;
    for (int it = gw * 8 + wave; it < I_OUT + I_1 + I_2; it += NGW * 8) { int r = it;
        if (r < I_OUT) { transpose_item(PIN(I_WOUT) + (size_t)layer * 1024 * 1024, 1024, 1024, 1024, (bf16_t*)(p.ws + WS_WTOUT), scr, r, lane); continue; } r -= I_OUT;
        if (r < I_1) { transpose_item(PIN(I_W1) + (size_t)layer * 1024 * 4096, 1024, 4096, 4096, (bf16_t*)(p.ws + WS_WT1), scr, r, lane); continue; } r -= I_1;
        transpose_item(PIN(I_W2) + (size_t)layer * 4096 * 1024, 4096, 1024, 1024, (bf16_t*)(p.ws + WS_WT2), scr, r, lane); }
    __syncthreads();
}
DI void sub_barrier(unsigned* cnt, unsigned target) {
    asm volatile("s_waitcnt vmcnt(0)" ::: "memory");
    __syncthreads();
    if (threadIdx.x == 0) {
        __builtin_amdgcn_fence(__ATOMIC_RELEASE, "agent"); asm volatile("s_waitcnt vmcnt(0)" ::: "memory");
        (void)__hip_atomic_fetch_add(cnt, 1u, __ATOMIC_RELAXED, __HIP_MEMORY_SCOPE_AGENT);
        unsigned sp = 0;
        while (__hip_atomic_load(cnt, __ATOMIC_RELAXED, __HIP_MEMORY_SCOPE_AGENT) < target) { __builtin_amdgcn_s_sleep(2); if (++sp > (1u << 22)) break; }
        __builtin_amdgcn_fence(__ATOMIC_ACQUIRE, "agent"); asm volatile("s_waitcnt vmcnt(0)" ::: "memory");
    }
    __syncthreads();
}
DI void phase_mix(const Params& p, int layer, unsigned char* lds, const XcdBarrier& xb) {
    if (blockIdx.x < 64) { rwkv_scan_block(p, layer, blockIdx.x, lds, xb); return; }
    const int nb = gridDim.x - 64, bi = blockIdx.x - 64; unsigned* cnt = (unsigned*)(p.ws + WS_BAR);
    { constexpr int N1 = 2080, N2 = 2 * 4 * NCH, N3 = 2 * 4 * NCH;
      for (int it = bi; it < N1 + N2 + N3; it += nb) { int r = it;
        if (r < N1) { s5_stage1_item(p, layer, r, lds); continue; } r -= N1;
        if (r < N2) { chunk_stageA<64, true>(p, layer, r, lds); continue; } r -= N2;
        chunk_stageA<32, false>(p, layer, r, lds); } }
    sub_barrier(cnt, (unsigned)nb * (unsigned)(3 * layer + 1));
    { constexpr int NB_B = (16 * 512 + 16 * 256) / 512, NB_S = 4096 / 512;
      for (int it = bi; it < NB_B + NB_S; it += nb) { const int t_ = otid();
        if (it < NB_B) { const int task = it * 512 + t_; if (task < 16 * 512) chunk_stageB_task<64, true>(p, task); else chunk_stageB_task<32, false>(p, task - 16 * 512); }
        else s5_prefix_task(p, layer, (it - NB_B) * 512 + t_); } }
    sub_barrier(cnt, (unsigned)nb * (unsigned)(3 * layer + 2));
    { constexpr int N1 = 2 * NCH, N2 = 2 * 4 * NCH, N3 = 2 * 4 * NCH;
      for (int it = bi; it < N1 + N2 + N3; it += nb) { int r = it;
        if (r < N1) { s5_stage3_item(p, layer, r, lds); continue; } r -= N1;
        if (r < N2) { chunk_stageC<64, true>(p, layer, r, lds); continue; } r -= N2;
        chunk_stageC<32, false>(p, layer, r, lds); } }
    sub_barrier(cnt, (unsigned)nb * (unsigned)(3 * layer + 3));
    for (int it = bi; it < NROW / 64; it += nb) s5_glu_item(p, layer, it, lds);
    __syncthreads();
    convert_late(p, layer, lds, bi, nb);
    if (layer < 3) mods_items(p, layer + 1, lds, bi, nb);
}
DI void phase_m3(const Params& p, int layer, unsigned char* lds) {
    for (int it = blockIdx.x; it < NROW / 16; it += gridDim.x) { const int t_ = otid(), r0 = it * 16 + (t_ >> 6) * 2, ln = t_ & 63;
        const FinIn fa = rwkv_finish_load(p, r0, ln), fb = rwkv_finish_load(p, r0 + 1, ln); rwkv_finish_row(p, layer, r0, ln, fa); rwkv_finish_row(p, layer, r0 + 1, ln, fb); }
}

__global__ void __launch_bounds__(512) mk_fwd(Params p) {
    cg::grid_group grid = cg::this_grid();
    volatile LAS unsigned* xst = (volatile LAS unsigned*)(smem + LDS_MAIN);
    if (threadIdx.x == 0) { xst[0] = 0u; xst[1] = 0u;
        const float** tab = (const float**)(smem + LDS_MAIN + 64);
#pragma unroll
        for (int i = 0; i < N_IN; ++i) tab[i] = p.in[i]; }
    __syncthreads();
    const XcdBarrier xb = xcd_barrier_post((unsigned*)(p.ws + WS_BAR), xst);
    for (int ph = p.ph_lo; ph < p.ph_hi; ++ph) {
        if (ph > p.ph_lo) { if (p.ph_lo < 0) grid.sync(); else xcd_barrier(xb); }
#if PROBE_MASK & 16
        for (int q_ = 0; q_ < 2; ++q_) xcd_barrier(xb);
#endif
        if (ph == 0) { phase_pre(p, smem); if (PROBE_MASK & 32) { __syncthreads(); phase_pre(p, smem); } continue; }
        if (ph == NPHASE - 1) { if (PH_EN(101)) phase_final(p); continue; }
        const int layer = (ph - 1) / 9, sub = (ph - 1) % 9;
        const float* modl = (const float*)(p.ws + WS_MOD) + (size_t)layer * 3 * 6144;
        if (sub == 1 || sub == 5 || sub == 7 || sub == 8) {
            EpiAll E{}; const bf16_t* A; const bf16_t* Bt; int N, K;
            if (sub == 1) { E.perm = true; E.mode = 0; E.O = (bf16_t*)(p.ws + WS_Z); A = (const bf16_t*)(p.ws + WS_H); Bt = (const bf16_t*)(p.ws + WS_WTIN); N = ZPAD; K = 1024; }
            else if (sub == 7) { E.perm = true; E.mode = 1; E.O = (bf16_t*)(p.ws + WS_HID); A = (const bf16_t*)(p.ws + WS_H); Bt = (const bf16_t*)(p.ws + WS_WT1); N = DFF; K = 1024; }
            else { const bool o = sub == 5; E.perm = false; E.mode = 2; E.out = p.out; E.xctx = (float*)(p.ws + WS_XCTX); E.gate = modl + (o ? 2048 : 5120);
                A = (const bf16_t*)(p.ws + (o ? WS_H : WS_HID)); Bt = (const bf16_t*)(p.ws + (o ? WS_WTOUT : WS_WT2)); N = 1024; K = o ? 1024 : 4096; }
            { const int nrep = ((PROBE_MASK & 128) && E.mode == 2) || ((PROBE_MASK & 256) && E.mode != 2) ? 2 : 1;
              for (int rep = 0; rep < nrep; ++rep) { if (rep && E.mode == 2) E.gate = (const float*)(p.ws + WS_ZERO); run_gemm(A, Bt, (layer == 3 && sub != 1) ? NLAT : NROW, N, K, E, (PG8_LAS unsigned char*)smem); } }
            continue;
        }
        switch (sub) {
        case 0: phase_norm(p, layer, 0, smem); if (PROBE_MASK & 8) phase_norm(p, layer, 0, smem); break;
        case 2: phase_m1(p, layer, smem); if (PROBE_MASK & 4) phase_m1(p, layer, smem); break;
        case 3: phase_mix(p, layer, smem, xb); break;
        case 4: phase_m3(p, layer, smem); if (PROBE_MASK & 64) phase_m3(p, layer, smem); break;
        case 6: phase_norm(p, layer, 1, smem); if (PROBE_MASK & 8) phase_norm(p, layer, 1, smem); break;
        }
    }
}

extern "C" void kernel_launch(void* const* d_in, const int* in_sizes, int n_in, void* d_out, int out_size, void* d_ws, size_t ws_size, hipStream_t stream) {
    static int grid = 0;
    if (grid == 0) {
        if (n_in != N_IN || ws_size < WS_END) { fprintf(stderr, "kernel_launch: unexpected n_in %d / ws %zu (need %zu)\n", n_in, ws_size, (size_t)WS_END); grid = -1; return; }
        int dev = 0, cus = 0, per_cu = 0;
        hipGetDevice(&dev); hipDeviceGetAttribute(&cus, hipDeviceAttributeMultiprocessorCount, dev);
        if (hipFuncSetAttribute((const void*)mk_fwd, hipFuncAttributeMaxDynamicSharedMemorySize, LDS_BYTES) != hipSuccess) { fprintf(stderr, "kernel_launch: hipFuncSetAttribute failed\n"); grid = -1; return; }
        hipOccupancyMaxActiveBlocksPerMultiprocessor(&per_cu, (const void*)mk_fwd, 512, LDS_BYTES);
        (void)hipGetLastError();
        if (per_cu < 1) per_cu = 1;
        grid = cus * 1;
        fprintf(stderr, "kernel_launch: cus %d per_cu %d grid %d\n", cus, per_cu, grid);
    }
    if (grid < 0) return;
    Params p{};
    for (int i = 0; i < N_IN; ++i) p.in[i] = (const float*)d_in[i];
    p.out = (float*)d_out; p.ws = (unsigned char*)d_ws;
    (void)hipMemsetAsync((unsigned char*)d_ws + WS_BAR, 0, (size_t)XCD_BAR_WORDS * 4, stream);
#if MULTI_LAUNCH
    for (int ph = 0; ph < NPHASE; ++ph) { p.ph_lo = ph; p.ph_hi = ph + 1; hipLaunchKernelGGL(mk_fwd, dim3(grid), dim3(512), LDS_BYTES, stream, p); }
#else
    p.ph_lo = 0; p.ph_hi = NPHASE;
    void* args[] = {&p};
    hipError_t e = hipLaunchCooperativeKernel((const void*)mk_fwd, dim3(grid), dim3(512), args, LDS_BYTES, stream);
    if (e != hipSuccess) fprintf(stderr, "cooperative launch failed: %s (grid %d)\n", hipGetErrorString(e), grid);
#endif
}
```
